# Optimizing an MI355X kernel written in HIP

```python
import jax, jax.numpy as jnp
from jax import lax
import numpy as np

D_MODEL = 1024
BATCH = 16
SEQ = 2048
DEPTH = 1

RNN_WIDTH = 1024
RNN_BLOCKS = 8
RNN_BLOCK_W = RNN_WIDTH // RNN_BLOCKS
CONV_WIDTH = 4
LRU_C = 8.0
GLA_HEADS = 4
GLA_DK = D_MODEL // 2
GLA_DV = D_MODEL
GLA_HEAD_K = GLA_DK // GLA_HEADS
GLA_HEAD_V = GLA_DV // GLA_HEADS
GLA_RANK = 16
GLA_TAU = 16.0
GLA_CHUNK = 64
N_GROUPS = 4
EXPERTS_PER_GROUP = 8
N_EXPERTS = N_GROUPS * EXPERTS_PER_GROUP
TOP_K = 2
EXPERT_FF = 512
MOE_BLOCK = 128
DN_ALPHA = (2.0 * DEPTH) ** 0.25
DN_BETA = (8.0 * DEPTH) ** -0.25
LN_EPS = 1e-5
RMS_EPS = 1e-6
IN_SPLITS = (RNN_WIDTH, RNN_WIDTH, GLA_DK, GLA_DK, GLA_DV, GLA_DV, GLA_RANK, D_MODEL, D_MODEL)
IN_COL_BETA = (DN_BETA, 1.0, 1.0, 1.0, DN_BETA, 1.0, 1.0, 1.0, 1.0)
IN_COLS = sum(IN_SPLITS)
SPLIT_POINTS = tuple(np.cumsum(IN_SPLITS)[:-1].tolist())

kernel_name = "hawk_gla_hier_moe_deepnorm_block"


def layer_norm(x, g, b):
    xf = x.astype(jnp.float32)
    mu = jnp.mean(xf, axis=-1, keepdims=True)
    var = jnp.mean(jnp.square(xf - mu), axis=-1, keepdims=True)
    y = (xf - mu) * lax.rsqrt(var + LN_EPS) * g.astype(jnp.float32) + b.astype(jnp.float32)
    return y.astype(x.dtype)


def causal_depthwise_conv(u, w, b):
    S = u.shape[1]
    up = jnp.pad(u, ((0, 0), (CONV_WIDTH - 1, 0), (0, 0)))
    out = b
    for k in range(CONV_WIDTH):
        out = out + w[k] * up[:, k:k + S]
    return out


def _linear_combine(c1, c2):
    a1, b1 = c1
    a2, b2 = c2
    return a1 * a2, a2 * b1 + b2


def rg_lru(u, w_a, b_a, w_x, b_x, lam):
    B, S, _ = u.shape
    ub = u.reshape(B, S, RNN_BLOCKS, RNN_BLOCK_W)
    r = jax.nn.sigmoid(jnp.einsum('bshi,hij->bshj', ub, w_a).reshape(B, S, RNN_WIDTH) + b_a)
    i = jax.nn.sigmoid(jnp.einsum('bshi,hij->bshj', ub, w_x).reshape(B, S, RNN_WIDTH) + b_x)
    log_a = -LRU_C * r.astype(jnp.float32) * jax.nn.softplus(-lam.astype(jnp.float32))
    a = jnp.exp(log_a)
    mult = jnp.sqrt(-jnp.expm1(2.0 * log_a))
    bvals = mult * (i * u).astype(jnp.float32)
    _, h = lax.associative_scan(_linear_combine, (a, bvals), axis=1)
    return h.astype(u.dtype)


def gla_chunked(q, k, v, log_alpha):
    B, S, H, K = q.shape
    V = v.shape[-1]
    C = GLA_CHUNK
    n = S // C
    q = q.reshape(B, n, C, H, K)
    k = k.reshape(B, n, C, H, K)
    v = v.reshape(B, n, C, H, V)
    bcum = jnp.cumsum(log_alpha.reshape(B, n, C, H, K), axis=2)
    b_last = bcum[:, :, -1:]
    q_dec = q * jnp.exp(bcum)
    k_inv = k * jnp.exp(-bcum)
    k_end = k * jnp.exp(b_last - bcum)
    mask = jnp.tril(jnp.ones((C, C), dtype=bool))
    scores = jnp.einsum('bnthk,bnshk->bnhts', q_dec, k_inv)
    scores = jnp.where(mask, scores, 0.0)
    o_intra = jnp.einsum('bnhts,bnshv->bnthv', scores, v)
    chunk_decay = jnp.exp(b_last[:, :, 0])

    def step(state, inp):
        qd, ke, vc, dec = inp
        o = jnp.einsum('bthk,bhkv->bthv', qd, state)
        state = dec[..., None] * state + jnp.einsum('bshk,bshv->bhkv', ke, vc)
        return state, o

    xs = (jnp.moveaxis(q_dec, 1, 0), jnp.moveaxis(k_end, 1, 0),
          jnp.moveaxis(v, 1, 0), jnp.moveaxis(chunk_decay, 1, 0))
    state0 = jnp.zeros((B, H, K, V), jnp.float32)
    _, o_inter = lax.scan(step, state0, xs)
    o = o_intra + jnp.moveaxis(o_inter, 0, 1)
    return o.reshape(B, S, H, V)


def hierarchical_moe(xf, w_rg, b_rg, w_re, b_re, w1, w3, w2):
    N, D = xf.shape
    g_logits = (xf @ w_rg + b_rg).astype(jnp.float32)
    p_group = jax.nn.softmax(g_logits, axis=-1)
    grp = jnp.argmax(g_logits, axis=-1).astype(jnp.int32)
    p_grp_sel = jnp.take_along_axis(p_group, grp[:, None], axis=1)[:, 0]
    e_logits = (xf @ w_re + b_re).astype(jnp.float32).reshape(N, N_GROUPS, EXPERTS_PER_GROUP)
    e_sel = jnp.take_along_axis(e_logits, grp[:, None, None], axis=1)[:, 0]
    p_exp = jax.nn.softmax(e_sel, axis=-1)
    top_p, top_i = lax.top_k(p_exp, TOP_K)
    top_p = top_p / jnp.sum(top_p, axis=-1, keepdims=True)
    weights = p_grp_sel[:, None] * top_p
    expert_id = grp[:, None] * EXPERTS_PER_GROUP + top_i.astype(jnp.int32)

    e_flat = expert_id.reshape(-1)
    w_flat = weights.reshape(-1)
    tok_flat = jnp.repeat(jnp.arange(N, dtype=jnp.int32), TOP_K)
    order = jnp.argsort(e_flat)
    e_s, w_s, tok_s = e_flat[order], w_flat[order], tok_flat[order]
    counts = jnp.zeros((N_EXPERTS,), jnp.int32).at[e_flat].add(1)
    offsets = jnp.cumsum(counts) - counts
    pcounts = (counts + MOE_BLOCK - 1) // MOE_BLOCK * MOE_BLOCK
    pend = jnp.cumsum(pcounts)
    poffsets = pend - pcounts
    rank = jnp.arange(N * TOP_K, dtype=jnp.int32) - offsets[e_s]
    dest = poffsets[e_s] + rank
    n_blocks = -(-(N * TOP_K) // MOE_BLOCK) + N_EXPERTS
    P = n_blocks * MOE_BLOCK
    buf_tok = jnp.zeros((P,), jnp.int32).at[dest].set(tok_s)
    buf_w = jnp.zeros((P,), jnp.float32).at[dest].set(w_s)
    block_start = jnp.arange(n_blocks, dtype=jnp.int32) * MOE_BLOCK
    blk_e = jnp.minimum(jnp.searchsorted(pend, block_start, side='right'), N_EXPERTS - 1)

    def run_block(args):
        tok_b, w_b, e_b = args
        xb = xf[tok_b]
        h = jax.nn.silu(xb @ w1[e_b]) * (xb @ w3[e_b])
        return (h @ w2[e_b]) * w_b[:, None]

    y = lax.map(run_block, (buf_tok.reshape(n_blocks, MOE_BLOCK),
                            buf_w.reshape(n_blocks, MOE_BLOCK).astype(xf.dtype), blk_e))
    return jax.ops.segment_sum(y.reshape(P, D), buf_tok, num_segments=N)


def hybrid_layer(x, w_in, b_in, conv_w, conv_b, rg_w_a, rg_b_a, rg_w_x, rg_b_x, rg_lambda,
                 gla_w_a2, gla_b_a, gla_norm_g, w_proj_rnn, w_proj_gla, w_o, b_o,
                 ln1_g, ln1_b, router_w_group, router_b_group, router_w_expert,
                 router_b_expert, exp_w1, exp_w3, exp_w2, ln2_g, ln2_b):
    B, S, D = x.shape
    proj = x @ w_in + b_in
    rx, ry, q, k, v, g, alr, ga, gb = jnp.split(proj, SPLIT_POINTS, axis=-1)

    u = causal_depthwise_conv(rx, conv_w, conv_b)
    h = rg_lru(u, rg_w_a, rg_b_a, rg_w_x, rg_b_x, rg_lambda)
    out_a = (h * jax.nn.gelu(ry)) @ w_proj_rnn

    log_alpha = jax.nn.log_sigmoid((alr @ gla_w_a2 + gla_b_a).astype(jnp.float32)) / GLA_TAU
    qh = q.reshape(B, S, GLA_HEADS, GLA_HEAD_K).astype(jnp.float32) * (GLA_HEAD_K ** -0.5)
    kh = k.reshape(B, S, GLA_HEADS, GLA_HEAD_K).astype(jnp.float32)
    vh = v.reshape(B, S, GLA_HEADS, GLA_HEAD_V).astype(jnp.float32)
    la = log_alpha.reshape(B, S, GLA_HEADS, GLA_HEAD_K)
    o = gla_chunked(qh, kh, vh, la)
    o = o * lax.rsqrt(jnp.mean(jnp.square(o), axis=-1, keepdims=True) + RMS_EPS)
    o = o * gla_norm_g.astype(jnp.float32).reshape(GLA_HEADS, GLA_HEAD_V)
    o = o.reshape(B, S, GLA_DV).astype(x.dtype) * jax.nn.silu(g)
    out_b = o @ w_proj_gla

    merged = jax.nn.sigmoid(ga) * out_a + jax.nn.sigmoid(gb) * out_b
    y_mix = merged @ w_o + b_o
    x1 = layer_norm(DN_ALPHA * x + y_mix, ln1_g, ln1_b)

    y_moe = hierarchical_moe(x1.reshape(B * S, D), router_w_group, router_b_group,
                             router_w_expert, router_b_expert, exp_w1, exp_w3, exp_w2)
    x2 = layer_norm(DN_ALPHA * x1 + y_moe.reshape(B, S, D), ln2_g, ln2_b)
    return x2


def setup_inputs(seed: int = 0) -> dict:
    key = jax.random.key(seed)
    ks = jax.random.split(key, 28)
    L = DEPTH
    D = D_MODEL

    def nrm(k, shape, scale):
        return jax.random.normal(k, shape, jnp.float32) * scale

    col_scale = jnp.concatenate([jnp.full((n,), s, jnp.float32) for n, s in zip(IN_SPLITS, IN_COL_BETA)])
    a_c = jax.random.uniform(ks[9], (L, RNN_WIDTH), jnp.float32, minval=0.9, maxval=0.999)
    a0 = a_c ** (1.0 / LRU_C)
    return {
        "x": nrm(ks[0], (BATCH, SEQ, D), 1.0),
        "w_in": nrm(ks[1], (L, D, IN_COLS), D ** -0.5) * col_scale,
        "b_in": nrm(ks[2], (L, IN_COLS), 0.02),
        "conv_w": nrm(ks[3], (L, CONV_WIDTH, RNN_WIDTH), CONV_WIDTH ** -0.5),
        "conv_b": nrm(ks[4], (L, RNN_WIDTH), 0.02),
        "rg_w_a": nrm(ks[5], (L, RNN_BLOCKS, RNN_BLOCK_W, RNN_BLOCK_W), RNN_BLOCK_W ** -0.5),
        "rg_b_a": nrm(ks[6], (L, RNN_WIDTH), 0.02),
        "rg_w_x": nrm(ks[7], (L, RNN_BLOCKS, RNN_BLOCK_W, RNN_BLOCK_W), RNN_BLOCK_W ** -0.5),
        "rg_b_x": nrm(ks[8], (L, RNN_WIDTH), 0.02),
        "rg_lambda": jnp.log(a0) - jnp.log1p(-a0),
        "gla_w_a2": nrm(ks[10], (L, GLA_RANK, GLA_DK), GLA_RANK ** -0.5),
        "gla_b_a": nrm(ks[11], (L, GLA_DK), 0.1),
        "gla_norm_g": 1.0 + nrm(ks[12], (L, GLA_DV), 0.02),
        "w_proj_rnn": nrm(ks[13], (L, RNN_WIDTH, D), RNN_WIDTH ** -0.5 * DN_BETA),
        "w_proj_gla": nrm(ks[14], (L, GLA_DV, D), GLA_DV ** -0.5 * DN_BETA),
        "w_o": nrm(ks[15], (L, D, D), D ** -0.5 * DN_BETA),
        "b_o": nrm(ks[16], (L, D), 0.02),
        "ln1_g": 1.0 + nrm(ks[17], (L, D), 0.02),
        "ln1_b": nrm(ks[18], (L, D), 0.02),
        "router_w_group": nrm(ks[19], (L, D, N_GROUPS), D ** -0.5),
        "router_b_group": nrm(ks[20], (L, N_GROUPS), 0.01),
        "router_w_expert": nrm(ks[21], (L, D, N_EXPERTS), D ** -0.5),
        "router_b_expert": nrm(ks[22], (L, N_EXPERTS), 0.01),
        "exp_w1": nrm(ks[23], (L, N_EXPERTS, D, EXPERT_FF), D ** -0.5 * DN_BETA),
        "exp_w3": nrm(ks[24], (L, N_EXPERTS, D, EXPERT_FF), D ** -0.5 * DN_BETA),
        "exp_w2": nrm(ks[25], (L, N_EXPERTS, EXPERT_FF, D), EXPERT_FF ** -0.5 * DN_BETA),
        "ln2_g": 1.0 + nrm(ks[26], (L, D), 0.02),
        "ln2_b": nrm(ks[27], (L, D), 0.02),
    }


def reference(x, w_in, b_in, conv_w, conv_b, rg_w_a, rg_b_a, rg_w_x, rg_b_x, rg_lambda,
              gla_w_a2, gla_b_a, gla_norm_g, w_proj_rnn, w_proj_gla, w_o, b_o,
              ln1_g, ln1_b, router_w_group, router_b_group, router_w_expert,
              router_b_expert, exp_w1, exp_w3, exp_w2, ln2_g, ln2_b):
    h = x
    for l in range(DEPTH):
        h = hybrid_layer(h, w_in[l], b_in[l], conv_w[l], conv_b[l], rg_w_a[l], rg_b_a[l],
                         rg_w_x[l], rg_b_x[l], rg_lambda[l], gla_w_a2[l], gla_b_a[l],
                         gla_norm_g[l], w_proj_rnn[l], w_proj_gla[l], w_o[l], b_o[l],
                         ln1_g[l], ln1_b[l], router_w_group[l], router_b_group[l],
                         router_w_expert[l], router_b_expert[l], exp_w1[l], exp_w3[l],
                         exp_w2[l], ln2_g[l], ln2_b[l])
    return h
```

```cpp
#include <hip/hip_runtime.h>
#include <cstdio>
#include <cstdint>

#ifndef MK_ONE_LAUNCH
#define MK_ONE_LAUNCH 1
#endif
#ifndef MK_STAGE
#define MK_STAGE 9
#endif

#define GAS __attribute__((address_space(1)))
#define LAS __attribute__((address_space(3)))
typedef unsigned short bf16_t;
typedef short bf16x8 __attribute__((ext_vector_type(8)));
typedef short s16x4 __attribute__((ext_vector_type(4)));
typedef float f32x4 __attribute__((ext_vector_type(4)));
typedef float f32x2 __attribute__((ext_vector_type(2)));
typedef unsigned u32x4 __attribute__((ext_vector_type(4)));
typedef unsigned u32x2 __attribute__((ext_vector_type(2)));
#define DI __device__ __forceinline__

typedef __bf16 bf16x2_t __attribute__((ext_vector_type(2)));
DI unsigned cvt_pk_bf16(float lo, float hi) { const f32x2 f = {lo, hi}; return __builtin_bit_cast(unsigned, __builtin_convertvector(f, bf16x2_t)); }
DI float bf_lo(unsigned u) { return __uint_as_float(u << 16); }
DI float bf_hi(unsigned u) { return __uint_as_float(u & 0xffff0000u); }
DI float bf2f(unsigned short b) { return __uint_as_float(((unsigned)b) << 16); }
DI unsigned short f2bf(float f) { return (unsigned short)(cvt_pk_bf16(f, 0.f) & 0xffffu); }
DI float fast_exp(float x) { return __builtin_amdgcn_exp2f(x * 1.4426950408889634f); }
DI float fast_rcp(float x) { return __builtin_amdgcn_rcpf(x); }
DI float sigmoid_f(float x) { return fast_rcp(1.0f + fast_exp(-x)); }
DI float silu_f(float x) { return x * sigmoid_f(x); }
DI float gelu_tanh_f(float x) {
    const float u = 1.5957691216057308f * (x + 0.044715f * x * x * x);
    return x * sigmoid_f(u);
}
#define LDS_WAIT() asm volatile("s_waitcnt lgkmcnt(0)" ::: "memory")
#define VM_WAIT() asm volatile("s_waitcnt vmcnt(0)" ::: "memory")
#define MFMA16(a, b, c) __builtin_amdgcn_mfma_f32_16x16x32_bf16((a), (b), (c), 0, 0, 0)

namespace pg8 {
#define PG8_LAS __attribute__((address_space(3)))
constexpr int BM = 256, BK = 64, HALF = 128, HTB = HALF * BK * 2  , STAGE_BYTES = 8 * HTB, NXCD = 8, WGM = 8;
__host__ __device__ __forceinline__ int lds_byte(int r, int c) { const int st = (r >> 4) * 2 + (c >> 5), rr = r & 15, cc = c & 31, ob = rr * 64 + cc * 2; return st * 1024 + (ob ^ (((ob >> 9) & 1) << 5)); }
__host__ __device__ __forceinline__ void stage_rc(int b, int& R, int& C) { const int st = b / 1024, sb = b % 1024, swz = sb ^ (((sb >> 9) & 1) << 5); R = (st >> 1) * 16 + swz / 64; C = (st & 1) * 32 + (swz % 64) / 2; }
__host__ __device__ __forceinline__ int perm32(int rho) { const int n = rho >> 4, i = rho & 15; return 8 * (i >> 2) + 4 * n + (i & 3); }

struct Unit { int pm, pn, e; };

struct StaticOrder {
    const char* A; const char* Bt; int K; int nM, nN, nwg, G, c;
    __device__ void init(const void* A_, const void* Bt_, int M, int N, int K_, int G_, int c_) { A = (const char*)A_; Bt = (const char*)Bt_; K = K_; nM = M / BM; nN = N / BM; nwg = nM * nN; G = G_; c = c_; }
    __device__ __forceinline__ bool next(int i, Unit& u) const {
        const long L = (long)i * G + c; if (L >= nwg) return false;
        int wgid = (int)L; { const int q = nwg / NXCD, r = nwg % NXCD, xcd = wgid % NXCD, off = wgid / NXCD; wgid = (xcd < r ? xcd * (q + 1) : r * (q + 1) + (xcd - r) * q) + off; }
        const int nig = WGM * nN, gid = wgid / nig, fm = gid * WGM, gsz = (nM - fm) < WGM ? (nM - fm) : WGM;
        u.pm = fm + ((wgid % nig) % gsz); u.pn = (wgid % nig) / gsz; u.e = 0; return true;
    }
    __device__ __forceinline__ const char* a_ptr(const Unit& u) const { return A + (size_t)u.pm * BM * K * 2; }
    __device__ __forceinline__ const char* b_ptr(const Unit& u) const { return Bt + (size_t)u.pn * BM * K * 2; }
    __device__ __forceinline__ void a_rows(const Unit&, const int (&)[2], const int (&)[2], unsigned (&)[2][2]) const {}
};

template <class Epi, class Sched, bool GATHER, bool ALIGN_EPI, bool SP2>
__device__ __forceinline__ void gemm_phase(PG8_LAS unsigned char* lds, const int K, const Sched& S, const Epi& E) {
    const int tid = threadIdx.x, wid = __builtin_amdgcn_readfirstlane(tid >> 6), lane = tid & 63, wr = wid >> 2, wc = wid & 3, fr = lane & 15, fq = lane >> 4;
    const int nt = K / BK;
    unsigned voffA[2], voffB[2]; int RA[2], CA[2];
#pragma unroll
    for (int i = 0; i < 2; ++i) { int R, C; stage_rc(tid * 16 + i * 8192, R, C); const int Rb = Epi::PERM ? ((R & ~31) + perm32(R & 31)) : R;
        RA[i] = R; CA[i] = C * 2; voffA[i] = (unsigned)(R * K + C) * 2u; voffB[i] = (unsigned)(Rb * K + C) * 2u; }
    const size_t kstep = (size_t)(BK * 2);
    const size_t hstep = (size_t)HALF * K * 2;
    const unsigned ldsw = (unsigned)wid * 1024u;
    const int aoff = lds_byte(wr * 64 + fr, fq * 8), boff = lds_byte(wc * 32 + fr, fq * 8);
#define PG8_SA(b, h) (((b) * 2 + (h)) * HTB)
#define PG8_SB(b, h) ((4 + (b) * 2 + (h)) * HTB)
#define PG8_STAGE2(bufoff, gbase, v0, v1) do { \
        __builtin_amdgcn_global_load_lds((const unsigned*)((const char*)(gbase) + (v0)), (PG8_LAS unsigned*)(lds + (bufoff) + ldsw), 16, 0, 0); \
        __builtin_amdgcn_global_load_lds((const unsigned*)((const char*)(gbase) + (v1)), (PG8_LAS unsigned*)(lds + (bufoff) + ldsw + 8192), 16, 0, 0); } while (0)
#define PG8_STAGE(bufoff, gbase, voff) PG8_STAGE2(bufoff, gbase, (voff)[0], (voff)[1])
#define PG8_STAGE_A(bufoff, abase, h, NXT) do { if constexpr (GATHER) { PG8_STAGE2(bufoff, abase, (NXT) ? gN[h][0] : gC[h][0], (NXT) ? gN[h][1] : gC[h][1]); } else { PG8_STAGE(bufoff, (abase) + (h) * hstep, voffA); } } while (0)
#define PG8_LDA(dst, b, h) do { _Pragma("unroll") for (int m = 0; m < 4; ++m) _Pragma("unroll") for (int k = 0; k < 2; ++k) dst[m][k] = *(const PG8_LAS bf16x8*)(lds + PG8_SA(b, h) + aoff + m * 2048 + k * 1024); } while (0)
#define PG8_LDB(dst, b, h) do { _Pragma("unroll") for (int n = 0; n < 2; ++n) _Pragma("unroll") for (int k = 0; k < 2; ++k) dst[n][k] = *(const PG8_LAS bf16x8*)(lds + PG8_SB(b, h) + boff + n * 2048 + k * 1024); } while (0)
#define PG8_MMA(ai, bj, At, Bt) do { __builtin_amdgcn_s_setprio(1); _Pragma("unroll") for (int m = 0; m < 4; ++m) _Pragma("unroll") for (int n = 0; n < 2; ++n) _Pragma("unroll") for (int k = 0; k < 2; ++k) \
        acc[ai][bj][m][n] = __builtin_amdgcn_mfma_f32_16x16x32_bf16(Bt[n][k], At[m][k], acc[ai][bj][m][n], 0, 0, 0); __builtin_amdgcn_s_setprio(0); } while (0)
#define PG8_WAIT_V(n) asm volatile("s_waitcnt vmcnt(" #n ")" ::: "memory")
#define PG8_WAIT_L(n) asm volatile("s_waitcnt lgkmcnt(" #n ")" ::: "memory")
#define PG8_BAR __builtin_amdgcn_s_barrier()
#define PG8_SCHED __builtin_amdgcn_sched_barrier(0)
    Unit cur, nxt; int ui = 0;
    if (!S.next(0, cur)) return;
    f32x4 acc[2][2][4][2];
#pragma unroll
    for (int a = 0; a < 2; ++a)
#pragma unroll
        for (int b = 0; b < 2; ++b)
#pragma unroll
            for (int m = 0; m < 4; ++m)
#pragma unroll
                for (int n = 0; n < 2; ++n) acc[a][b][m][n] = (f32x4){0.f, 0.f, 0.f, 0.f};
    bf16x8 At[4][2], B0[2][2], B1[2][2];
    unsigned gC[2][2] = {{0u, 0u}, {0u, 0u}}, gN[2][2] = {{0u, 0u}, {0u, 0u}};
    const char* cA = S.a_ptr(cur); const char* cB = S.b_ptr(cur);
    if constexpr (GATHER) S.a_rows(cur, RA, CA, gC);
    if constexpr (SP2) {
        PG8_STAGE(PG8_SB(0, 0), cB, voffB); PG8_STAGE(PG8_SB(0, 1), cB + hstep, voffB); PG8_STAGE_A(PG8_SA(0, 0), cA, 0, false); PG8_STAGE_A(PG8_SA(0, 1), cA, 1, false);
        if (wr == 1) PG8_BAR;
        PG8_WAIT_V(2); PG8_BAR;
        PG8_STAGE(PG8_SB(1, 0), cB + kstep, voffB); PG8_STAGE_A(PG8_SA(1, 0), cA + kstep, 0, false); PG8_STAGE(PG8_SB(1, 1), cB + hstep + kstep, voffB);
        PG8_WAIT_V(6); PG8_BAR;
    } else {
        PG8_STAGE(PG8_SB(0, 0), cB, voffB); PG8_STAGE_A(PG8_SA(0, 0), cA, 0, false); PG8_STAGE(PG8_SB(0, 1), cB + hstep, voffB); PG8_STAGE_A(PG8_SA(0, 1), cA, 1, false);
        if (wr == 1) PG8_BAR;
        PG8_WAIT_V(4); PG8_BAR;
        PG8_STAGE(PG8_SB(1, 0), cB + kstep, voffB); PG8_STAGE_A(PG8_SA(1, 0), cA + kstep, 0, false); PG8_STAGE(PG8_SB(1, 1), cB + hstep + kstep, voffB);
        PG8_WAIT_V(6); PG8_BAR;
    }
    for (;;) {
        const bool has_next = S.next(ui + 1, nxt);
        const char* nA = has_next ? S.a_ptr(nxt) : cA; const char* nB = has_next ? S.b_ptr(nxt) : cB;
        if constexpr (GATHER) { if (has_next) S.a_rows(nxt, RA, CA, gN); else {
#pragma unroll
            for (int h = 0; h < 2; ++h) { gN[h][0] = gC[h][0]; gN[h][1] = gC[h][1]; } } }
        for (int t = 0; t < nt; t += 2) {
            const bool last = (t == nt - 2);
            const char* a1 = cA + (size_t)(t + 1) * kstep;
            const char* a2 = last ? nA : cA + (size_t)(t + 2) * kstep; const char* b2 = last ? nB : cB + (size_t)(t + 2) * kstep;
            const char* a3 = a2 + kstep; const char* b3 = b2 + kstep;
            if constexpr (SP2) {
            PG8_LDB(B0, 0, 0); PG8_LDB(B1, 0, 1); PG8_SCHED; PG8_LDA(At, 0, 0); PG8_STAGE_A(PG8_SA(1, 1), a1, 1, false);
            PG8_WAIT_V(8); PG8_WAIT_L(0); PG8_BAR; PG8_MMA(0, 0, At, B0); PG8_MMA(0, 1, At, B1); PG8_BAR; PG8_SCHED;
            PG8_LDA(At, 0, 1); PG8_STAGE(PG8_SB(0, 0), b2, voffB); PG8_STAGE(PG8_SB(0, 1), b2 + hstep, voffB); PG8_STAGE_A(PG8_SA(0, 0), a2, 0, last);
            PG8_WAIT_V(8); PG8_WAIT_L(0); PG8_BAR; PG8_MMA(1, 0, At, B0); PG8_MMA(1, 1, At, B1); PG8_BAR; PG8_SCHED;
            PG8_LDB(B0, 1, 0); PG8_LDB(B1, 1, 1); PG8_SCHED; PG8_LDA(At, 1, 0); PG8_STAGE_A(PG8_SA(0, 1), a2, 1, last);
            PG8_WAIT_V(8); PG8_WAIT_L(0); PG8_BAR; PG8_MMA(0, 0, At, B0); PG8_MMA(0, 1, At, B1); PG8_BAR; PG8_SCHED;
            PG8_LDA(At, 1, 1); PG8_STAGE(PG8_SB(1, 0), b3, voffB); PG8_STAGE(PG8_SB(1, 1), b3 + hstep, voffB); PG8_STAGE_A(PG8_SA(1, 0), a3, 0, last);
            PG8_WAIT_V(8); PG8_WAIT_L(0); PG8_BAR; PG8_MMA(1, 0, At, B0); PG8_MMA(1, 1, At, B1); PG8_BAR; PG8_SCHED;
            } else {
            PG8_LDB(B0, 0, 0); PG8_SCHED; PG8_LDA(At, 0, 0); PG8_STAGE_A(PG8_SA(1, 1), a1, 1, false);
            PG8_WAIT_L(8); PG8_BAR; PG8_WAIT_L(0); PG8_MMA(0, 0, At, B0); PG8_BAR; PG8_SCHED;
            PG8_LDB(B1, 0, 1); PG8_STAGE(PG8_SB(0, 0), b2, voffB);
            PG8_BAR; PG8_WAIT_L(0); PG8_MMA(0, 1, At, B1); PG8_BAR;
            PG8_LDA(At, 0, 1); PG8_STAGE_A(PG8_SA(0, 0), a2, 0, last);
            PG8_BAR; PG8_WAIT_L(0); PG8_MMA(1, 0, At, B0); PG8_BAR; PG8_SCHED;
            PG8_STAGE(PG8_SB(0, 1), b2 + hstep, voffB);
            PG8_WAIT_V(6); PG8_BAR; PG8_MMA(1, 1, At, B1); PG8_BAR;
            PG8_LDB(B0, 1, 0); PG8_SCHED; PG8_LDA(At, 1, 0); PG8_STAGE_A(PG8_SA(0, 1), a2, 1, last);
            PG8_WAIT_L(8); PG8_BAR; PG8_WAIT_L(0); PG8_MMA(0, 0, At, B0); PG8_BAR; PG8_SCHED;
            PG8_LDB(B1, 1, 1); PG8_STAGE(PG8_SB(1, 0), b3, voffB);
            PG8_BAR; PG8_WAIT_L(0); PG8_MMA(0, 1, At, B1); PG8_BAR;
            PG8_LDA(At, 1, 1); PG8_STAGE_A(PG8_SA(1, 0), a3, 0, last);
            PG8_BAR; PG8_WAIT_L(0); PG8_MMA(1, 0, At, B0); PG8_BAR; PG8_SCHED;
            PG8_STAGE(PG8_SB(1, 1), b3 + hstep, voffB);
            PG8_WAIT_V(6); PG8_BAR; PG8_MMA(1, 1, At, B1); PG8_BAR;
            }
        }
        if constexpr (ALIGN_EPI) { if (wr == 0) PG8_BAR; }
        E(acc, cur, wr, wc, fr, fq);
        if (!has_next) break;
#pragma unroll
        for (int a = 0; a < 2; ++a)
#pragma unroll
            for (int b = 0; b < 2; ++b)
#pragma unroll
                for (int m = 0; m < 4; ++m)
#pragma unroll
                    for (int n = 0; n < 2; ++n) acc[a][b][m][n] = (f32x4){0.f, 0.f, 0.f, 0.f};
        cur = nxt; cA = nA; cB = nB; ++ui;
        if constexpr (GATHER) {
#pragma unroll
            for (int h = 0; h < 2; ++h) { gC[h][0] = gN[h][0]; gC[h][1] = gN[h][1]; } }
        if constexpr (ALIGN_EPI) { if (wr == 1) PG8_BAR; }
    }
    PG8_WAIT_V(0);
    if constexpr (!ALIGN_EPI) { if (wr == 0) PG8_BAR; }
    PG8_BAR;
#undef PG8_SA
#undef PG8_SB
#undef PG8_STAGE
#undef PG8_STAGE2
#undef PG8_STAGE_A
#undef PG8_LDA
#undef PG8_LDB
#undef PG8_MMA
#undef PG8_WAIT_V
#undef PG8_WAIT_L
#undef PG8_BAR
#undef PG8_SCHED
}
}

constexpr int NB = 16, SEQ = 2048, D = 1024, NTOK = NB * SEQ;
constexpr int IN_COLS = 7184, NPROJ = 7168, ALR_COL = 5120;
constexpr int NEXP = 32, FF = 512, NWAVES = 8;
constexpr float DN_ALPHA = 1.189207115002721f, LN_EPS = 1e-5f, RMS_EPS = 1e-6f, QSCALE = 0.08838834764831845f;
constexpr int MAXROWS = 2 * NTOK + NEXP * 256;

constexpr size_t MiB = 1u << 20;
constexpr size_t WS_CTL = 0, CTL_ZERO_BYTES = 1 * MiB;
constexpr size_t WS_RGT = 1 * MiB;
constexpr size_t WS_TOKE = 1 * MiB + 512 * 1024;
constexpr size_t WS_TOKW = WS_TOKE + 256 * 1024;
constexpr size_t WS_ALR = 2 * MiB;
constexpr size_t WS_WR = 4 * MiB, WS_WG = 6 * MiB, WS_WO = 8 * MiB;
constexpr size_t WS_RX = 10 * MiB, WS_RY = 74 * MiB, WS_Q = 138 * MiB, WS_K = 170 * MiB, WS_V = 202 * MiB, WS_G = 266 * MiB;
constexpr size_t WS_E13 = 330 * MiB, WS_E2 = 394 * MiB;
constexpr size_t WS_WIN = 426 * MiB, WS_XB = 440 * MiB;
constexpr size_t WS_ORAW = 426 * MiB, WS_PBUF = 490 * MiB, WS_DEC = 506 * MiB, WS_SSQ = 507 * MiB;
constexpr size_t WS_ROWS = 511 * MiB;
constexpr size_t WS_MERGED = 426 * MiB;
constexpr size_t WS_TMP = 138 * MiB;
constexpr size_t WS_X1B = 10 * MiB;
constexpr size_t WS_H = 74 * MiB;
constexpr size_t WS_SLOTS = 146 * MiB;
constexpr size_t WS_END = 512 * MiB;
static_assert(WS_H + (size_t)MAXROWS * FF * 2 <= WS_SLOTS && WS_SLOTS + (size_t)2 * NTOK * D * 2 <= WS_E13 && WS_ROWS + 3 * (size_t)MAXROWS * 4 <= WS_END, "d_ws map");
constexpr int CW_BAR = 4096;
constexpr int CW_TS = 8192;
constexpr int CW_WGCNT = 131072;

constexpr int RING_BYTES = 131072, AUX_OFF = 131072, LDSCTL_OFF = 147456, LDS_BYTES = 148480;

#define XB_TMO      128
#define XB_XCNT(j)  (256  + 64 * (j))
#define XB_XSUB(j)  (1280 + 64 * (j))
#define XB_XGEN(j)  (2304 + 64 * (j))
#define XB_TOP      3328
#define XB_TOPGEN   3392
#define XCD_BAR_WORDS 3456
#define XB_SPIN_CAP (1u << 18)
__device__ __forceinline__ unsigned xb_ld(unsigned* p)              { return __hip_atomic_load(p, __ATOMIC_RELAXED, __HIP_MEMORY_SCOPE_AGENT); }
__device__ __forceinline__ unsigned xb_add(unsigned* p, unsigned v) { return __hip_atomic_fetch_add(p, v, __ATOMIC_RELAXED, __HIP_MEMORY_SCOPE_AGENT); }
__device__ __forceinline__ unsigned xb_xcc_id() { return (unsigned)__builtin_amdgcn_s_getreg((3 << 11) | 20) & 0xFu; }
#define XB_SPIN(cond, bar) do { unsigned _sp = 0; while (cond) { __builtin_amdgcn_s_sleep(1); \
    if ((++_sp & 255u) == 0u) { if (xb_ld(&(bar)[XB_TMO])) break; if (_sp > XB_SPIN_CAP) { atomicAdd(&(bar)[XB_TMO], 1u); break; } } } } while (0)
struct XcdBarrier { unsigned* bar; unsigned x; volatile LAS unsigned* st; };
__device__ __forceinline__ XcdBarrier xcd_barrier_post(unsigned* bar, volatile LAS unsigned* st) {
    XcdBarrier b; b.bar = bar; b.x = xb_xcc_id(); b.st = st;
    if (threadIdx.x == 0) (void)xb_add(&bar[XB_XCNT(b.x)], 1u);
    return b;
}
__device__ __forceinline__ void xcd_barrier_complete(unsigned* bar, unsigned x, unsigned& nloc, unsigned& nx) {
    const unsigned G = gridDim.x * gridDim.y * gridDim.z;
    unsigned sum, cnt, mine, sp = 0u;
    for (;;) {
        sum = 0u; cnt = 0u; mine = 0u;
#pragma unroll
        for (unsigned j = 0; j < 16; ++j) { const unsigned c = xb_ld(&bar[XB_XCNT(j)]); sum += c; cnt += (c > 0u) ? 1u : 0u; mine = (j == x) ? c : mine; }
        if (sum == G) break;
        __builtin_amdgcn_s_sleep(1);
        if ((++sp & 255u) == 0u) { if (xb_ld(&bar[XB_TMO])) break; if (sp > XB_SPIN_CAP) { atomicAdd(&bar[XB_TMO], 1u); break; } }
    }
    nloc = mine > 0u ? mine : 1u; nx = cnt > 0u ? cnt : 1u;
}
__device__ __forceinline__ void xcd_barrier(const XcdBarrier& b) {
    asm volatile("s_waitcnt vmcnt(0)" ::: "memory");
    __syncthreads();
    if (threadIdx.x == 0) {
        unsigned* bar = b.bar;
        __builtin_amdgcn_s_waitcnt(0);
        unsigned nloc = b.st[0], nx = b.st[1];
        if (nloc == 0u) { xcd_barrier_complete(bar, b.x, nloc, nx); b.st[0] = nloc; b.st[1] = nx; }
        const unsigned old = xb_add(&bar[XB_XSUB(b.x)], 1u);
        const unsigned gen = old / nloc;
        if (old + 1u == (gen + 1u) * nloc) {
            __builtin_amdgcn_fence(__ATOMIC_RELEASE, "agent");
            asm volatile("s_waitcnt vmcnt(0)" ::: "memory");
            const unsigned og = xb_add(&bar[XB_TOP], 1u);
            const unsigned tg = og / nx;
            if (og + 1u == (tg + 1u) * nx) xb_add(&bar[XB_TOPGEN], 1u);
            else XB_SPIN(xb_ld(&bar[XB_TOPGEN]) == tg, bar);
            __builtin_amdgcn_fence(__ATOMIC_ACQUIRE, "agent");
            xb_add(&bar[XB_XGEN(b.x)], 1u);
            asm volatile("s_waitcnt vmcnt(0)" ::: "memory");
        } else {
            XB_SPIN(xb_ld(&bar[XB_XGEN(b.x)]) == gen, bar);
            __builtin_amdgcn_fence(__ATOMIC_ACQUIRE, "agent");
            asm volatile("s_waitcnt vmcnt(0)" ::: "memory");
        }
    }
    __syncthreads();
}

struct Frame {
    LAS unsigned char* lds;
    unsigned* ctl;
    int tid, lane, wave, vcu, G;
    float* out;
    unsigned char* ws;
};
struct Args { const float* in[28]; float* out; unsigned char* ws; int ph_lo, ph_hi; };
enum InIdx { I_X = 0, I_WIN, I_BIN, I_CONVW, I_CONVB, I_RGWA, I_RGBA, I_RGWX, I_RGBX, I_LAM, I_GWA2, I_GBA, I_GNORM, I_WPR, I_WPG, I_WO, I_BO, I_LN1G, I_LN1B,
             I_RWG, I_RBG, I_RWE, I_RBE, I_EW1, I_EW3, I_EW2, I_LN2G, I_LN2B };
template <class T> DI T* wsp(Frame& F, size_t off) { return (T*)(F.ws + off); }

DI float wave_sum(float v) {
#pragma unroll
    for (int o = 1; o < 64; o <<= 1) v += __shfl_xor(v, o);
    return v;
}
DI int idx16(int lane) { return ((lane >> 5) & 1) * 8 + ((lane >> 4) & 1) * 4 + ((lane >> 3) & 1) * 2 + ((lane >> 2) & 1); }
DI float reduce16(const float (&a)[16], int lane) {
    float b[8], c[4], d[2];
    { const bool hi = (lane & 32) != 0;
#pragma unroll
      for (int i = 0; i < 8; ++i) { const float keep = hi ? a[i + 8] : a[i], send = hi ? a[i] : a[i + 8]; b[i] = keep + __shfl_xor(send, 32); } }
    { const bool hi = (lane & 16) != 0;
#pragma unroll
      for (int i = 0; i < 4; ++i) { const float keep = hi ? b[i + 4] : b[i], send = hi ? b[i] : b[i + 4]; c[i] = keep + __shfl_xor(send, 16); } }
    { const bool hi = (lane & 8) != 0;
#pragma unroll
      for (int i = 0; i < 2; ++i) { const float keep = hi ? c[i + 2] : c[i], send = hi ? c[i] : c[i + 2]; d[i] = keep + __shfl_xor(send, 8); } }
    float e; { const bool hi = (lane & 4) != 0; const float keep = hi ? d[1] : d[0], send = hi ? d[0] : d[1]; e = keep + __shfl_xor(send, 4); }
    e += __shfl_xor(e, 2); e += __shfl_xor(e, 1);
    return e;
}

DI void transpose_item(const float* src, int ld_src, bf16_t* dst, int ld_dst, LAS float* scr, int lane) {
#pragma unroll 8
    for (int i = 0; i < 32; ++i) { const int kk = 2 * i + (lane >> 5); scr[kk * 33 + (lane & 31)] = src[(size_t)kk * ld_src + (lane & 31)]; }
    LDS_WAIT(); asm volatile("" ::: "memory");
    const int c = lane & 7;
#pragma unroll
    for (int j = 0; j < 4; ++j) { const int n = (lane >> 3) + 8 * j; const LAS float* s = scr + (8 * c) * 33 + n;
        u32x4 o; o.x = cvt_pk_bf16(s[0 * 33], s[1 * 33]); o.y = cvt_pk_bf16(s[2 * 33], s[3 * 33]); o.z = cvt_pk_bf16(s[4 * 33], s[5 * 33]); o.w = cvt_pk_bf16(s[6 * 33], s[7 * 33]);
        *(u32x4*)(dst + (size_t)n * ld_dst + 8 * c) = o; }
    LDS_WAIT(); asm volatile("" ::: "memory");
}
DI void p0_prologue(Frame& F, const Args& A) {
    LAS float* scr = (LAS float*)(F.lds + F.wave * 8704);
    LAS float* walr = (LAS float*)(F.lds + 81920);
    const int gw = F.vcu * NWAVES + F.wave, NGW = F.G * NWAVES, lane = F.lane;
    const float* w_in = A.in[I_WIN];
    for (int i = F.tid; i < 16 * 1024; i += NWAVES * 64) { const int k = i >> 4, r = i & 15; walr[r * 1024 + k] = w_in[(size_t)k * IN_COLS + ALR_COL + r]; }
    __syncthreads();
    constexpr int N_WIN = 16 * 224, N_SQ = 3 * 512, N_RG = 128, N_E13 = 32 * 512, N_E2 = 32 * 256;
    constexpr int NITEMS = N_WIN + N_SQ + N_RG + N_E13 + N_E2;
    for (int it0 = gw; it0 < NITEMS; it0 += NGW) {
        int it = it0;
        if (it < N_WIN) { const int kb = it / 224, nb = it % 224, n0 = 32 * nb, sc = n0 + (n0 >= ALR_COL ? 16 : 0);
            transpose_item(w_in + (size_t)(64 * kb) * IN_COLS + sc, IN_COLS, wsp<bf16_t>(F, WS_WIN) + (size_t)n0 * 1024 + 64 * kb, 1024, scr, lane); continue; }
        it -= N_WIN;
        if (it < N_SQ) { const int mat = it / 512, r = it % 512, kb = r / 32, nb = r % 32;
            const size_t so = (size_t)(64 * kb) * 1024 + 32 * nb, dof = (size_t)(32 * nb) * 1024 + 64 * kb;
            if (mat == 0) transpose_item(A.in[I_WPR] + so, 1024, wsp<bf16_t>(F, WS_WR) + dof, 1024, scr, lane);
            else if (mat == 1) transpose_item(A.in[I_WPG] + so, 1024, wsp<bf16_t>(F, WS_WG) + dof, 1024, scr, lane);
            else transpose_item(A.in[I_WO] + so, 1024, wsp<bf16_t>(F, WS_WO) + dof, 1024, scr, lane);
            continue; }
        it -= N_SQ;
        if (it < N_RG) { const int bg = it / 8, r = it % 8, kb = r / 4, nb = r % 4, blk = bg >> 1, gate = bg & 1;
            const size_t so = (size_t)blk * 16384 + (64 * kb) * 128 + 32 * nb; bf16_t* dp = wsp<bf16_t>(F, WS_RGT) + (size_t)bg * 16384 + (32 * nb) * 128 + 64 * kb;
            if (gate) transpose_item(A.in[I_RGWX] + so, 128, dp, 128, scr, lane); else transpose_item(A.in[I_RGWA] + so, 128, dp, 128, scr, lane);
            continue; }
        it -= N_RG;
        if (it < N_E13) { const int e = it / 512, r = it % 512, which = r / 256, r2 = r % 256, kb = r2 / 16, nb = r2 % 16, n0 = 32 * nb;
            const int nd = 256 * (n0 / 128) + 128 * which + (n0 % 128);
            const size_t so = (size_t)e * (1024 * 512) + (size_t)(64 * kb) * 512 + n0; bf16_t* dp = wsp<bf16_t>(F, WS_E13) + (size_t)e * (1024 * 1024) + (size_t)nd * 1024 + 64 * kb;
            if (which) transpose_item(A.in[I_EW3] + so, 512, dp, 1024, scr, lane); else transpose_item(A.in[I_EW1] + so, 512, dp, 1024, scr, lane);
            continue; }
        it -= N_E13;
        { const int e = it / 256, r = it % 256, kb = r / 32, nb = r % 32;
            const float* W = A.in[I_EW2] + (size_t)e * (512 * 1024);
            transpose_item(W + (size_t)(64 * kb) * 1024 + 32 * nb, 1024, wsp<bf16_t>(F, WS_E2) + (size_t)e * (1024 * 512) + (size_t)(32 * nb) * 512 + 64 * kb, 512, scr, lane); }
    }
    const float* x = A.in[I_X]; bf16_t* xb = wsp<bf16_t>(F, WS_XB); float* alr = wsp<float>(F, WS_ALR);
    const float balr = A.in[I_BIN][ALR_COL + idx16(lane)];
    for (int m = 2 * gw; m < NTOK; m += 2 * NGW) {
        f32x4 xv[2][4];
#pragma unroll
        for (int r = 0; r < 2; ++r)
#pragma unroll
            for (int j = 0; j < 4; ++j) xv[r][j] = *((const f32x4*)(x + (size_t)(m + r) * D) + lane + 64 * j);
#pragma unroll
        for (int r = 0; r < 2; ++r)
#pragma unroll
            for (int j = 0; j < 4; ++j) { u32x2 w; w.x = cvt_pk_bf16(xv[r][j].x, xv[r][j].y); w.y = cvt_pk_bf16(xv[r][j].z, xv[r][j].w);
                *(u32x2*)(xb + (size_t)(m + r) * D + 4 * lane + 256 * j) = w; }
        float a0[16], a1[16];
#pragma unroll
        for (int rr = 0; rr < 16; ++rr) { a0[rr] = 0.f; a1[rr] = 0.f; }
#pragma unroll
        for (int j = 0; j < 4; ++j) {
#pragma unroll
            for (int rr = 0; rr < 16; ++rr) { const f32x4 wv = *(const LAS f32x4*)(walr + rr * 1024 + 256 * j + 4 * lane);
                a0[rr] += xv[0][j].x * wv.x + xv[0][j].y * wv.y + xv[0][j].z * wv.z + xv[0][j].w * wv.w;
                a1[rr] += xv[1][j].x * wv.x + xv[1][j].y * wv.y + xv[1][j].z * wv.z + xv[1][j].w * wv.w; }
            __builtin_amdgcn_sched_barrier(0); }
        const float t0 = reduce16(a0, lane) + balr, t1 = reduce16(a1, lane) + balr;
        if ((lane & 3) == 0) { alr[(size_t)m * 16 + idx16(lane)] = t0; alr[(size_t)(m + 1) * 16 + idx16(lane)] = t1; }
    }
}

using pg8::Unit;
struct EpiProj {
    static constexpr bool PERM = true;
    bf16_t *rx, *ry, *q, *k, *v, *g, *ga, *gb; const float* bias;
    DI void operator()(const f32x4 (&acc)[2][2][4][2], const Unit& u, int wr, int wc, int fr, int fq) const {
        const int pn = u.pn; bf16_t* base; int ldc = 1024, ct;
        if (pn < 4) { base = rx; ct = pn; } else if (pn < 8) { base = ry; ct = pn - 4; } else if (pn < 10) { base = q; ldc = 512; ct = pn - 8; } else if (pn < 12) { base = k; ldc = 512; ct = pn - 10; }
        else if (pn < 16) { base = v; ct = pn - 12; } else if (pn < 20) { base = g; ct = pn - 16; } else if (pn < 24) { base = ga; ct = pn - 20; } else { base = gb; ct = pn - 24; }
        const int row0 = u.pm * 256 + wr * 64 + fr, col0 = ct * 256 + wc * 32 + 8 * fq, bcol0 = pn * 256 + (pn >= 20 ? 16 : 0) + wc * 32 + 8 * fq;
        f32x4 bv[2][2];
#pragma unroll
        for (int bj = 0; bj < 2; ++bj)
#pragma unroll
            for (int n = 0; n < 2; ++n) bv[bj][n] = *(const f32x4*)(bias + bcol0 + bj * 128 + 4 * n);
#pragma unroll
        for (int ai = 0; ai < 2; ++ai)
#pragma unroll
            for (int m = 0; m < 4; ++m) { bf16_t* rowp = base + (size_t)(row0 + ai * 128 + m * 16) * ldc + col0;
#pragma unroll
                for (int bj = 0; bj < 2; ++bj) { const f32x4 v0 = acc[ai][bj][m][0] + bv[bj][0], v1 = acc[ai][bj][m][1] + bv[bj][1];
                    u32x4 w; w.x = cvt_pk_bf16(v0[0], v0[1]); w.y = cvt_pk_bf16(v0[2], v0[3]); w.z = cvt_pk_bf16(v1[0], v1[1]); w.w = cvt_pk_bf16(v1[2], v1[3]);
                    *(u32x4*)(rowp + bj * 128) = w; } }
    }
};
DI void unpack8(const u32x4 w, float (&f)[8]) { f[0] = bf_lo(w.x); f[1] = bf_hi(w.x); f[2] = bf_lo(w.y); f[3] = bf_hi(w.y); f[4] = bf_lo(w.z); f[5] = bf_hi(w.z); f[6] = bf_lo(w.w); f[7] = bf_hi(w.w); }
struct EpiMergeA {
    static constexpr bool PERM = true;
    const bf16_t* ga; float* tmp;
    DI void operator()(const f32x4 (&acc)[2][2][4][2], const Unit& u, int wr, int wc, int fr, int fq) const {
        const int row0 = u.pm * 256 + wr * 64 + fr, col0 = u.pn * 256 + wc * 32 + 8 * fq;
#pragma unroll
        for (int ai = 0; ai < 2; ++ai)
#pragma unroll
            for (int m = 0; m < 4; ++m) { const size_t off = (size_t)(row0 + ai * 128 + m * 16) * D + col0;
#pragma unroll
                for (int bj = 0; bj < 2; ++bj) { float gf[8]; unpack8(*(const u32x4*)(ga + off + bj * 128), gf);
                    f32x4 o0, o1;
#pragma unroll
                    for (int j = 0; j < 4; ++j) { o0[j] = sigmoid_f(gf[j]) * acc[ai][bj][m][0][j]; o1[j] = sigmoid_f(gf[4 + j]) * acc[ai][bj][m][1][j]; }
                    *(f32x4*)(tmp + off + bj * 128) = o0; *(f32x4*)(tmp + off + bj * 128 + 4) = o1; } }
    }
};
struct EpiMergeB {
    static constexpr bool PERM = true;
    const bf16_t* gb; const float* tmp; bf16_t* merged; int use_acc;
    DI void operator()(const f32x4 (&acc)[2][2][4][2], const Unit& u, int wr, int wc, int fr, int fq) const {
        const int row0 = u.pm * 256 + wr * 64 + fr, col0 = u.pn * 256 + wc * 32 + 8 * fq;
#pragma unroll
        for (int ai = 0; ai < 2; ++ai)
#pragma unroll
            for (int m = 0; m < 4; ++m) { const size_t off = (size_t)(row0 + ai * 128 + m * 16) * D + col0;
#pragma unroll
                for (int bj = 0; bj < 2; ++bj) { float gf[8]; unpack8(*(const u32x4*)(gb + off + bj * 128), gf);
                    const f32x4 t0 = *(const f32x4*)(tmp + off + bj * 128), t1 = *(const f32x4*)(tmp + off + bj * 128 + 4);
                    f32x4 o0, o1;
#pragma unroll
                    for (int j = 0; j < 4; ++j) { o0[j] = t0[j] + (use_acc ? sigmoid_f(gf[j]) * acc[ai][bj][m][0][j] : 0.f); o1[j] = t1[j] + (use_acc ? sigmoid_f(gf[4 + j]) * acc[ai][bj][m][1][j] : 0.f); }
                    u32x4 w; w.x = cvt_pk_bf16(o0[0], o0[1]); w.y = cvt_pk_bf16(o0[2], o0[3]); w.z = cvt_pk_bf16(o1[0], o1[1]); w.w = cvt_pk_bf16(o1[2], o1[3]);
                    *(u32x4*)(merged + off + bj * 128) = w; } }
    }
};
struct EpiWo {
    static constexpr bool PERM = false;
    const float* x; const float* bo; float* z;
    DI void operator()(const f32x4 (&acc)[2][2][4][2], const Unit& u, int wr, int wc, int fr, int fq) const {
        const int row0 = u.pm * 256 + wr * 64 + fr, col0 = u.pn * 256 + wc * 32 + 4 * fq;
        f32x4 bv[2][2];
#pragma unroll
        for (int bj = 0; bj < 2; ++bj)
#pragma unroll
            for (int n = 0; n < 2; ++n) bv[bj][n] = *(const f32x4*)(bo + col0 + bj * 128 + n * 16);
#pragma unroll
        for (int ai = 0; ai < 2; ++ai)
#pragma unroll
            for (int m = 0; m < 4; ++m) { const size_t off = (size_t)(row0 + ai * 128 + m * 16) * D + col0;
#pragma unroll
                for (int bj = 0; bj < 2; ++bj)
#pragma unroll
                    for (int n = 0; n < 2; ++n) { const f32x4 xv = *(const f32x4*)(x + off + bj * 128 + n * 16);
                        *(f32x4*)(z + off + bj * 128 + n * 16) = xv * DN_ALPHA + acc[ai][bj][m][n] + bv[bj][n]; } }
    }
};
struct EpiExp1 {
    static constexpr bool PERM = true;
    bf16_t* h;
    DI void operator()(const f32x4 (&acc)[2][2][4][2], const Unit& u, int wr, int wc, int fr, int fq) const {
        const int row0 = u.pm * 256 + wr * 64 + fr, col0 = u.pn * 128 + wc * 32 + 8 * fq;
#pragma unroll
        for (int ai = 0; ai < 2; ++ai)
#pragma unroll
            for (int m = 0; m < 4; ++m) { f32x4 o0, o1;
#pragma unroll
                for (int j = 0; j < 4; ++j) { o0[j] = silu_f(acc[ai][0][m][0][j]) * acc[ai][1][m][0][j]; o1[j] = silu_f(acc[ai][0][m][1][j]) * acc[ai][1][m][1][j]; }
                u32x4 w; w.x = cvt_pk_bf16(o0[0], o0[1]); w.y = cvt_pk_bf16(o0[2], o0[3]); w.z = cvt_pk_bf16(o1[0], o1[1]); w.w = cvt_pk_bf16(o1[2], o1[3]);
                *(u32x4*)(h + (size_t)(row0 + ai * 128 + m * 16) * FF + col0) = w; }
    }
};
struct EpiExp2 {
    static constexpr bool PERM = true;
    const int* row_slot; const float* row_w; bf16_t* slots;
    DI void operator()(const f32x4 (&acc)[2][2][4][2], const Unit& u, int wr, int wc, int fr, int fq) const {
        const int row0 = u.pm * 256 + wr * 64 + fr, col0 = u.pn * 256 + wc * 32 + 8 * fq;
#pragma unroll
        for (int ai = 0; ai < 2; ++ai)
#pragma unroll
            for (int m = 0; m < 4; ++m) { const int r = row0 + ai * 128 + m * 16; const int slot = row_slot[r]; const float w8 = row_w[r];
                if (slot >= 0) {
#pragma unroll
                    for (int bj = 0; bj < 2; ++bj) { const f32x4 v0 = acc[ai][bj][m][0] * w8, v1 = acc[ai][bj][m][1] * w8;
                        u32x4 w; w.x = cvt_pk_bf16(v0[0], v0[1]); w.y = cvt_pk_bf16(v0[2], v0[3]); w.z = cvt_pk_bf16(v1[0], v1[1]); w.w = cvt_pk_bf16(v1[2], v1[3]);
                        *(u32x4*)(slots + (size_t)slot * D + col0 + bj * 128) = w; } } }
    }
};
struct MoeOrder {
    const char* A; const char* Bt; int K; size_t bstride; const LAS int* ts; const int* row_tok; int G, c, gather;
    DI bool next(int i, Unit& u) const {
        const int L = i * G + c, ntile = ts[32]; if (L >= 4 * ntile) return false;
        const int tile = L >> 2, lane = threadIdx.x & 63;
        const int v = ts[lane < 32 ? lane + 1 : 32];
        const unsigned long long mk = __ballot(lane < 32 && v <= tile);
        u.pm = tile; u.pn = L & 3; u.e = __builtin_amdgcn_readfirstlane((int)__popcll(mk)); return true;
    }
    DI const char* a_ptr(const Unit& u) const { return gather ? A : A + (size_t)u.pm * 256 * K * 2; }
    DI const char* b_ptr(const Unit& u) const { return Bt + (size_t)u.e * bstride + (size_t)u.pn * 256 * K * 2; }
    DI void a_rows(const Unit& u, const int (&RA)[2], const int (&CA)[2], unsigned (&g)[2][2]) const {
#pragma unroll
        for (int h = 0; h < 2; ++h)
#pragma unroll
            for (int i = 0; i < 2; ++i) g[h][i] = (unsigned)row_tok[u.pm * 256 + h * 128 + RA[i]] * (unsigned)(K * 2) + (unsigned)CA[i];
    }
};

DI void phase_gla_pre(Frame& F, const Args& A) {
    LAS unsigned char* L = F.lds;
    constexpr int oQT = 0, oKT = 17408, oKE = 34816, oALR = 52224, oSEG = 56320, RS = 272;
    const int tid = F.tid, lane = F.lane, w = F.wave, kk = tid & 127, seg = tid >> 7, g = lane >> 4, fr = lane & 15;
    bf16_t* Q = wsp<bf16_t>(F, WS_Q); bf16_t* K = wsp<bf16_t>(F, WS_K); const float* ALR = wsp<float>(F, WS_ALR);
    bf16_t* PB = wsp<bf16_t>(F, WS_PBUF); float* DEC = wsp<float>(F, WS_DEC);
    for (int item = F.vcu; item < NB * 4 * 32; item += F.G) {
        const int b = item >> 7, hd = (item >> 5) & 3, n = item & 31;
        const size_t tok0 = (size_t)b * SEQ + n * 64;
        float w2[16];
#pragma unroll
        for (int r = 0; r < 16; ++r) w2[r] = A.in[I_GWA2][r * 512 + hd * 128 + kk];
        const float ba = A.in[I_GBA][hd * 128 + kk];
        __syncthreads();
#pragma unroll
        for (int c = tid; c < 1024; c += 512) { const int row = c >> 4, c16 = c & 15; const size_t go = (tok0 + row) * 512 + hd * 128 + c16 * 8;
            *(LAS u32x4*)(L + oQT + row * RS + c16 * 16) = *(const u32x4*)(Q + go); *(LAS u32x4*)(L + oKT + row * RS + c16 * 16) = *(const u32x4*)(K + go); }
        if (tid < 256) *(LAS f32x4*)(L + oALR + tid * 16) = *(const f32x4*)(ALR + tok0 * 16 + tid * 4);
        __syncthreads();
        float cs[16]; float run = 0.f;
#pragma unroll
        for (int i = 0; i < 16; ++i) { const LAS f32x4* ar = (const LAS f32x4*)(L + oALR + (16 * seg + i) * 64); const f32x4 a0 = ar[0], a1 = ar[1], a2 = ar[2], a3 = ar[3];
            float z = ba + a0.x * w2[0] + a0.y * w2[1] + a0.z * w2[2] + a0.w * w2[3] + a1.x * w2[4] + a1.y * w2[5] + a1.z * w2[6] + a1.w * w2[7]
                         + a2.x * w2[8] + a2.y * w2[9] + a2.z * w2[10] + a2.w * w2[11] + a3.x * w2[12] + a3.y * w2[13] + a3.z * w2[14] + a3.w * w2[15];
            const float la = (fminf(z, 0.f) - __logf(1.0f + fast_exp(-fabsf(z)))) * (1.0f / 16.0f);
            run += la; cs[i] = run; }
        LAS float* SEGp = (LAS float*)(L + oSEG);
        SEGp[seg * 128 + kk] = run;
        __syncthreads();
        float off = 0.f, bl = 0.f;
#pragma unroll
        for (int s = 0; s < 4; ++s) { const float v = SEGp[s * 128 + kk]; bl += v; off += (s < seg) ? v : 0.f; }
        const float eb = fast_exp(bl);
#pragma unroll
        for (int i = 0; i < 16; ++i) { const int t = 16 * seg + i; const float E = fast_exp(off + cs[i]), Ei = fast_rcp(E);
            LAS unsigned short* qp = (LAS unsigned short*)(L + oQT + t * RS) + kk; LAS unsigned short* kp = (LAS unsigned short*)(L + oKT + t * RS) + kk; LAS unsigned short* ep = (LAS unsigned short*)(L + oKE + t * RS) + kk;
            const float qv = bf2f(*qp), kv = bf2f(*kp);
            *qp = f2bf(qv * QSCALE * E); *kp = f2bf(kv * Ei); *ep = f2bf(kv * Ei * eb); }
        if (seg == 0) DEC[(size_t)item * 128 + kk] = eb;
        __syncthreads();
        const int tt = w >> 1;
#pragma unroll
        for (int j = 0; j < 2; ++j) { const int st = 2 * (w & 1) + j; f32x4 acc = {0.f, 0.f, 0.f, 0.f};
#pragma unroll
            for (int ks = 0; ks < 4; ++ks) { const bf16x8 a = *(const LAS bf16x8*)(L + oKT + (16 * st + fr) * RS + (32 * ks + 8 * g) * 2); const bf16x8 bq = *(const LAS bf16x8*)(L + oQT + (16 * tt + fr) * RS + (32 * ks + 8 * g) * 2);
                acc = MFMA16(a, bq, acc); }
            const int t = 16 * tt + fr, s0 = 16 * st + 4 * g;
            u32x2 o; o.x = cvt_pk_bf16(s0 + 0 <= t ? acc[0] : 0.f, s0 + 1 <= t ? acc[1] : 0.f); o.y = cvt_pk_bf16(s0 + 2 <= t ? acc[2] : 0.f, s0 + 3 <= t ? acc[3] : 0.f);
            *(u32x2*)(PB + (size_t)item * 4096 + t * 64 + s0) = o; }
#pragma unroll
        for (int c = tid; c < 1024; c += 512) { const int row = c >> 4, c16 = c & 15; const size_t go = (tok0 + row) * 512 + hd * 128 + c16 * 8;
            *(u32x4*)(Q + go) = *(const LAS u32x4*)(L + oQT + row * RS + c16 * 16); *(u32x4*)(K + go) = *(const LAS u32x4*)(L + oKE + row * RS + c16 * 16); }
    }
}

DI bf16x8 tr_pair(const LAS unsigned char* p, int rowstride4) {
    const s16x4 lo = __builtin_amdgcn_ds_read_tr16_b64_v4i16((LAS s16x4*)p);
    const s16x4 hi = __builtin_amdgcn_ds_read_tr16_b64_v4i16((LAS s16x4*)(p + rowstride4));
    return __builtin_shufflevector(lo, hi, 0, 1, 2, 3, 4, 5, 6, 7);
}
DI void phase_gla_chain(Frame& F, const Args& A) {
    LAS unsigned char* L = F.lds;
    constexpr int BUF = 53760, oQD = 0, oKE = 17408, oV = 34816, oP = 44032, oDEC = 53248, oST = 2 * BUF, RS = 272, RV = 144;
    const int tid = F.tid, lane = F.lane, w = F.wave, g = lane >> 4, fr = lane & 15, q4 = fr >> 2, p4 = fr & 3;
    const bf16_t* Q = wsp<bf16_t>(F, WS_Q); const bf16_t* K = wsp<bf16_t>(F, WS_K); const bf16_t* V = wsp<bf16_t>(F, WS_V);
    const bf16_t* PB = wsp<bf16_t>(F, WS_PBUF); const float* DEC = wsp<float>(F, WS_DEC);
    bf16_t* ORAW = wsp<bf16_t>(F, WS_ORAW); float* SSQ = wsp<float>(F, WS_SSQ);
    for (int chain = F.vcu; chain < 256; chain += F.G) {
        const int b = chain >> 4, hd = (chain >> 2) & 3, vs = chain & 3;
        const int item0 = b * 128 + hd * 32; const size_t tokb = (size_t)b * SEQ;
        f32x4 S[4];
#pragma unroll
        for (int i = 0; i < 4; ++i) S[i] = (f32x4){0.f, 0.f, 0.f, 0.f};
        u32x4 pq[2], pk[2], pv, pp; float pd = 0.f;
        const int r16 = tid >> 4, c16 = tid & 15, r8 = tid >> 3, c8 = tid & 7;
#define GC_LOAD(n_) do { const size_t t0_ = tokb + (size_t)(n_) * 64; const int it_ = item0 + (n_); \
            pq[0] = *(const u32x4*)(Q + (t0_ + r16) * 512 + hd * 128 + c16 * 8); pq[1] = *(const u32x4*)(Q + (t0_ + r16 + 32) * 512 + hd * 128 + c16 * 8); \
            pk[0] = *(const u32x4*)(K + (t0_ + r16) * 512 + hd * 128 + c16 * 8); pk[1] = *(const u32x4*)(K + (t0_ + r16 + 32) * 512 + hd * 128 + c16 * 8); \
            pv = *(const u32x4*)(V + (t0_ + r8) * 1024 + hd * 256 + vs * 64 + c8 * 8); pp = *(const u32x4*)(PB + (size_t)it_ * 4096 + r8 * 64 + c8 * 8); \
            if (tid < 128) pd = DEC[(size_t)it_ * 128 + tid]; } while (0)
#define GC_WRITE(bo_) do { *(LAS u32x4*)(L + (bo_) + oQD + r16 * RS + c16 * 16) = pq[0]; *(LAS u32x4*)(L + (bo_) + oQD + (r16 + 32) * RS + c16 * 16) = pq[1]; \
            *(LAS u32x4*)(L + (bo_) + oKE + r16 * RS + c16 * 16) = pk[0]; *(LAS u32x4*)(L + (bo_) + oKE + (r16 + 32) * RS + c16 * 16) = pk[1]; \
            *(LAS u32x4*)(L + (bo_) + oV + r8 * RV + c8 * 16) = pv; *(LAS u32x4*)(L + (bo_) + oP + r8 * RV + c8 * 16) = pp; \
            if (tid < 128) *(LAS float*)(L + (bo_) + oDEC + tid * 4) = pd; } while (0)
        __syncthreads();
        for (int i = tid; i < 64 * RS / 16; i += 512) *(LAS u32x4*)(L + oST + i * 16) = (u32x4){0u, 0u, 0u, 0u};
        GC_LOAD(0); GC_WRITE(0);
        __syncthreads();
        const int tt = w >> 1, trow = 16 * tt + fr;
        for (int n = 0; n < 32; ++n) {
            const int cur = (n & 1) * BUF;
            if (n + 1 < 32) GC_LOAD(n + 1);
            bf16x8 pf[2], qf[4];
#pragma unroll
            for (int ks = 0; ks < 2; ++ks) pf[ks] = *(const LAS bf16x8*)(L + cur + oP + trow * RV + (32 * ks + 8 * g) * 2);
#pragma unroll
            for (int ks = 0; ks < 4; ++ks) qf[ks] = *(const LAS bf16x8*)(L + cur + oQD + trow * RS + (32 * ks + 8 * g) * 2);
            float ss = 0.f;
#pragma unroll
            for (int j = 0; j < 2; ++j) { const int vt = 2 * (w & 1) + j; f32x4 o = {0.f, 0.f, 0.f, 0.f};
#pragma unroll
                for (int ks = 0; ks < 2; ++ks) { const bf16x8 vf = tr_pair(L + cur + oV + (32 * ks + 8 * g + q4) * RV + (16 * vt + 4 * p4) * 2, 4 * RV); o = MFMA16(vf, pf[ks], o); }
#pragma unroll
                for (int ks = 0; ks < 4; ++ks) { const bf16x8 sf = *(const LAS bf16x8*)(L + oST + (16 * vt + fr) * RS + (32 * ks + 8 * g) * 2); o = MFMA16(sf, qf[ks], o); }
                u32x2 ob; ob.x = cvt_pk_bf16(o[0], o[1]); ob.y = cvt_pk_bf16(o[2], o[3]);
                *(u32x2*)(ORAW + (tokb + (size_t)n * 64 + trow) * 1024 + hd * 256 + vs * 64 + 16 * vt + 4 * g) = ob;
                ss += o[0] * o[0] + o[1] * o[1] + o[2] * o[2] + o[3] * o[3]; }
            ss += __shfl_xor(ss, 16); ss += __shfl_xor(ss, 32);
            if (g == 0) SSQ[((tokb + (size_t)n * 64 + trow) * 4 + hd) * 8 + vs * 2 + (w & 1)] = ss;
            const f32x4 d4 = *(const LAS f32x4*)(L + cur + oDEC + (16 * w + 4 * g) * 4);
#pragma unroll
            for (int vt = 0; vt < 4; ++vt) S[vt] = S[vt] * d4;
#pragma unroll
            for (int ks = 0; ks < 2; ++ks) { const bf16x8 kf = tr_pair(L + cur + oKE + (32 * ks + 8 * g + q4) * RS + (16 * w + 4 * p4) * 2, 4 * RS);
#pragma unroll
                for (int vt = 0; vt < 4; ++vt) { const bf16x8 vf = tr_pair(L + cur + oV + (32 * ks + 8 * g + q4) * RV + (16 * vt + 4 * p4) * 2, 4 * RV); S[vt] = MFMA16(kf, vf, S[vt]); } }
            __syncthreads();
#pragma unroll
            for (int vt = 0; vt < 4; ++vt) { u32x2 sb; sb.x = cvt_pk_bf16(S[vt][0], S[vt][1]); sb.y = cvt_pk_bf16(S[vt][2], S[vt][3]);
                *(LAS u32x2*)(L + oST + (16 * vt + fr) * RS + (16 * w + 4 * g) * 2) = sb; }
            if (n + 1 < 32) GC_WRITE(BUF - cur);
            __syncthreads();
        }
#undef GC_LOAD
#undef GC_WRITE
    }
}

DI void phase_gla_fix(Frame& F, const Args& A) {
    const bf16_t* ORAW = wsp<bf16_t>(F, WS_ORAW); bf16_t* G = wsp<bf16_t>(F, WS_G); const float* SSQ = wsp<float>(F, WS_SSQ); const float* gn = A.in[I_GNORM];
    const size_t total = (size_t)NTOK * 128, stride = (size_t)F.G * 512;
    for (size_t idx = (size_t)F.vcu * 512 + F.tid; idx < total; idx += stride) {
        const size_t tok = idx >> 7; const int c8 = (int)(idx & 127), v0 = 8 * c8, hd = v0 >> 8;
        const f32x4 s0 = *(const f32x4*)(SSQ + (tok * 4 + hd) * 8), s1 = *(const f32x4*)(SSQ + (tok * 4 + hd) * 8 + 4);
        const float rs = __builtin_amdgcn_rsqf(((s0.x + s0.y) + (s0.z + s0.w) + (s1.x + s1.y) + (s1.z + s1.w)) * (1.0f / 256.0f) + RMS_EPS);
        float of[8], gf[8]; unpack8(*(const u32x4*)(ORAW + tok * 1024 + v0), of); unpack8(*(const u32x4*)(G + tok * 1024 + v0), gf);
        const f32x4 n0 = *(const f32x4*)(gn + v0), n1 = *(const f32x4*)(gn + v0 + 4);
        float r[8];
#pragma unroll
        for (int j = 0; j < 4; ++j) { r[j] = of[j] * rs * n0[j] * silu_f(gf[j]); r[4 + j] = of[4 + j] * rs * n1[j] * silu_f(gf[4 + j]); }
        u32x4 wv; wv.x = cvt_pk_bf16(r[0], r[1]); wv.y = cvt_pk_bf16(r[2], r[3]); wv.z = cvt_pk_bf16(r[4], r[5]); wv.w = cvt_pk_bf16(r[6], r[7]);
        *(u32x4*)(G + tok * 1024 + v0) = wv;
    }
}
DI void phase_rnn_chain(Frame& F, const Args& A) {
    LAS unsigned char* L = F.lds;
    constexpr int oU = 0, RU = 272, oA = 34816, oB = 68608, RAB = 528, oH = 34816, RH = 272, oSA = 102400, oSB = 104448, oHC = 106496, oCW = 107008, oGW = 109568;
    const int tid = F.tid, lane = F.lane, w = F.wave, g = lane >> 4, fr = lane & 15, wt = w >> 1, wn = w & 1;
    const bf16_t* RX = wsp<bf16_t>(F, WS_RX); bf16_t* RY = wsp<bf16_t>(F, WS_RY); const bf16_t* RGT = wsp<bf16_t>(F, WS_RGT);
    for (int chain = F.vcu; chain < 256; chain += F.G) {
        const int b = chain >> 4, blk = (chain >> 1) & 7, half = chain & 1, C0 = blk * 128, OC0 = C0 + half * 64;
        __syncthreads();
        for (int i = tid; i < 640; i += 512) { const int k = i >> 7, c = i & 127; ((LAS float*)(L + oCW))[i] = (k < 4) ? A.in[I_CONVW][k * 1024 + C0 + c] : A.in[I_CONVB][C0 + c]; }
        if (tid < 128) ((LAS float*)(L + oHC))[tid] = 0.f;
        for (int i = tid; i < 2048; i += 512) { const int row = i >> 4, c16 = i & 15, G2 = row >> 6, ocl = row & 63;
            *(LAS u32x4*)(L + oGW + row * RU + c16 * 16) = *(const u32x4*)(RGT + ((size_t)(blk * 2 + G2) * 128 + half * 64 + ocl) * 128 + c16 * 8); }
        float ba[2], bx[2], c8[2];
#pragma unroll
        for (int nt = 0; nt < 2; ++nt) { const int oc = half * 64 + 32 * wn + 16 * nt + fr;
            ba[nt] = A.in[I_RGBA][C0 + oc]; bx[nt] = A.in[I_RGBX][C0 + oc]; c8[nt] = 8.0f * log1pf(expf(-A.in[I_LAM][C0 + oc])); }
        const int tl = tid >> 4, cg = tid & 15;
        u32x4 xr[7], yr[2];
#define RN_LOADX(t0_) do { _Pragma("unroll") for (int i_ = 0; i_ < 7; ++i_) { const int si_ = (t0_) + 4 * tl - 3 + i_; \
            xr[i_] = (si_ >= 0) ? *(const u32x4*)(RX + ((size_t)b * SEQ + si_) * 1024 + C0 + 8 * cg) : (u32x4){0u, 0u, 0u, 0u}; } } while (0)
        RN_LOADX(0);
        __syncthreads();
        for (int j = 0; j < SEQ / 128; ++j) {
            const int t0 = j * 128;
            { f32x4 cw[5][2];
#pragma unroll
              for (int k = 0; k < 5; ++k) { cw[k][0] = *(const LAS f32x4*)(L + oCW + (k * 128 + 8 * cg) * 4); cw[k][1] = *(const LAS f32x4*)(L + oCW + (k * 128 + 8 * cg + 4) * 4); }
              float xf[7][8];
#pragma unroll
              for (int i = 0; i < 7; ++i) unpack8(xr[i], xf[i]);
#pragma unroll
              for (int i = 0; i < 4; ++i) { float u8[8];
#pragma unroll
                  for (int c = 0; c < 8; ++c) { float u = cw[4][c >> 2][c & 3];
#pragma unroll
                      for (int k = 0; k < 4; ++k) u += cw[k][c >> 2][c & 3] * xf[i + k][c];
                      u8[c] = u; }
                  u32x4 uw; uw.x = cvt_pk_bf16(u8[0], u8[1]); uw.y = cvt_pk_bf16(u8[2], u8[3]); uw.z = cvt_pk_bf16(u8[4], u8[5]); uw.w = cvt_pk_bf16(u8[6], u8[7]);
                  *(LAS u32x4*)(L + oU + (4 * tl + i) * RU + cg * 16) = uw; } }
            __syncthreads();
            if (j + 1 < SEQ / 128) RN_LOADX(t0 + 128);
#pragma unroll
            for (int i = 0; i < 2; ++i) { const int idx = tid + 512 * i, tok = idx >> 3, cgp = idx & 7; yr[i] = *(const u32x4*)(RY + ((size_t)b * SEQ + t0 + tok) * 1024 + OC0 + 8 * cgp); }
            f32x4 aa[2][2], ax[2][2];
#pragma unroll
            for (int mt = 0; mt < 2; ++mt)
#pragma unroll
                for (int nt = 0; nt < 2; ++nt) { aa[mt][nt] = (f32x4){0.f, 0.f, 0.f, 0.f}; ax[mt][nt] = (f32x4){0.f, 0.f, 0.f, 0.f}; }
#pragma unroll
            for (int ks = 0; ks < 4; ++ks)
#pragma unroll
                for (int mt = 0; mt < 2; ++mt) { const bf16x8 af = *(const LAS bf16x8*)(L + oU + (32 * wt + 16 * mt + fr) * RU + (32 * ks + 8 * g) * 2);
#pragma unroll
                    for (int nt = 0; nt < 2; ++nt) { const bf16x8 b0 = *(const LAS bf16x8*)(L + oGW + (32 * wn + 16 * nt + fr) * RU + (32 * ks + 8 * g) * 2), b1 = *(const LAS bf16x8*)(L + oGW + (64 + 32 * wn + 16 * nt + fr) * RU + (32 * ks + 8 * g) * 2);
                        aa[mt][nt] = MFMA16(af, b0, aa[mt][nt]); ax[mt][nt] = MFMA16(af, b1, ax[mt][nt]); } }
#pragma unroll
            for (int mt = 0; mt < 2; ++mt)
#pragma unroll
                for (int nt = 0; nt < 2; ++nt) { const int o = 32 * wn + 16 * nt + fr, tk = 32 * wt + 16 * mt + 4 * g; f32x4 av, bv;
#pragma unroll
                    for (int r = 0; r < 4; ++r) { const float uval = bf2f(*((const LAS unsigned short*)(L + oU + (tk + r) * RU) + half * 64 + o));
                        const float rg = sigmoid_f(aa[mt][nt][r] + ba[nt]), ig = sigmoid_f(ax[mt][nt][r] + bx[nt]);
                        const float a = fast_exp(-c8[nt] * rg); const float mult = __builtin_amdgcn_sqrtf(fmaxf(1.0f - a * a, 0.f));
                        av[r] = a; bv[r] = mult * ig * uval; }
                    *(LAS f32x4*)(L + oA + o * RAB + tk * 4) = av; *(LAS f32x4*)(L + oB + o * RAB + tk * 4) = bv; }
            __syncthreads();
            { const int ch = tid >> 3, sg = tid & 7; float a16[16], h16[16];
#pragma unroll
              for (int q = 0; q < 4; ++q) { const f32x4 av = *(const LAS f32x4*)(L + oA + ch * RAB + (16 * sg + 4 * q) * 4), bv = *(const LAS f32x4*)(L + oB + ch * RAB + (16 * sg + 4 * q) * 4);
#pragma unroll
                  for (int r = 0; r < 4; ++r) { a16[4 * q + r] = av[r]; h16[4 * q + r] = bv[r]; } }
              float ac = 1.f, hl = 0.f;
#pragma unroll
              for (int i = 0; i < 16; ++i) { hl = a16[i] * hl + h16[i]; ac *= a16[i]; h16[i] = hl; a16[i] = ac; }
              ((LAS float*)(L + oSA))[ch * 8 + sg] = ac; ((LAS float*)(L + oSB))[ch * 8 + sg] = hl;
              __syncthreads();
              float carry = ((const LAS float*)(L + oHC))[(j & 1) * 64 + ch];
#pragma unroll
              for (int s = 0; s < 7; ++s) { const float sa = ((const LAS float*)(L + oSA))[ch * 8 + s], sb = ((const LAS float*)(L + oSB))[ch * 8 + s]; carry = (s < sg) ? sa * carry + sb : carry; }
#pragma unroll
              for (int i = 0; i < 16; ++i) { const float h = h16[i] + a16[i] * carry; h16[i] = h; *(LAS float*)(L + oH + (16 * sg + i) * RH + ch * 4) = h; }
              if (sg == 7) ((LAS float*)(L + oHC))[((j + 1) & 1) * 64 + ch] = h16[15]; }
            __syncthreads();
#pragma unroll
            for (int i = 0; i < 2; ++i) { const int idx = tid + 512 * i, tok = idx >> 3, cgp = idx & 7; float yf[8]; unpack8(yr[i], yf);
                const f32x4 h0 = *(const LAS f32x4*)(L + oH + tok * RH + cgp * 32), h1 = *(const LAS f32x4*)(L + oH + tok * RH + cgp * 32 + 16);
                float r[8];
#pragma unroll
                for (int c = 0; c < 4; ++c) { r[c] = h0[c] * gelu_tanh_f(yf[c]); r[4 + c] = h1[c] * gelu_tanh_f(yf[4 + c]); }
                u32x4 wv; wv.x = cvt_pk_bf16(r[0], r[1]); wv.y = cvt_pk_bf16(r[2], r[3]); wv.z = cvt_pk_bf16(r[4], r[5]); wv.w = cvt_pk_bf16(r[6], r[7]);
                *(u32x4*)(RY + ((size_t)b * SEQ + t0 + tok) * 1024 + OC0 + 8 * cgp) = wv; }
        }
#undef RN_LOADX
    }
}

DI void phase_ln1_router(Frame& F, const Args& A, const float* zsrc, float zscale) {
    LAS unsigned char* L = F.lds;
    LAS float* WRE = (LAS float*)L;
    LAS float* WRG = (LAS float*)(L + AUX_OFF);
    LAS int* HIST = (LAS int*)(L + LDSCTL_OFF + 64);
    const int tid = F.tid, lane = F.lane, w = F.wave;
    float* X1 = F.out; bf16_t* X1B = wsp<bf16_t>(F, WS_X1B); int* TOKE = wsp<int>(F, WS_TOKE); float* TOKW = wsp<float>(F, WS_TOKW);
    __syncthreads();
    for (int i = tid; i < 32 * 1024; i += 512) { const int k = i >> 5, e = i & 31; WRE[e * 1024 + k] = A.in[I_RWE][i]; }
    for (int i = tid; i < 4 * 1024; i += 512) { const int k = i >> 2, e = i & 3; WRG[e * 1024 + k] = A.in[I_RWG][i]; }
    if (tid < 32) HIST[tid] = 0;
    __syncthreads();
    f32x4 g1[4], b1[4];
#pragma unroll
    for (int j = 0; j < 4; ++j) { g1[j] = *((const f32x4*)A.in[I_LN1G] + lane + 64 * j); b1[j] = *((const f32x4*)A.in[I_LN1B] + lane + 64 * j); }
    const int TPW = NTOK / F.G;
    for (int it = 0; it < TPW / 16; ++it) {
        const int m = F.vcu * TPW + it * 16 + w * 2;
        f32x4 xv[2][4];
#pragma unroll
        for (int r = 0; r < 2; ++r) { float s = 0.f;
#pragma unroll
            for (int j = 0; j < 4; ++j) { xv[r][j] = *((const f32x4*)(zsrc + (size_t)(m + r) * D) + lane + 64 * j) * zscale; s += (xv[r][j].x + xv[r][j].y) + (xv[r][j].z + xv[r][j].w); }
            const float mean = wave_sum(s) * (1.f / D); float s2 = 0.f;
#pragma unroll
            for (int j = 0; j < 4; ++j) { xv[r][j] = xv[r][j] - mean; s2 += (xv[r][j].x * xv[r][j].x + xv[r][j].y * xv[r][j].y) + (xv[r][j].z * xv[r][j].z + xv[r][j].w * xv[r][j].w); }
            const float rstd = __builtin_amdgcn_rsqf(wave_sum(s2) * (1.f / D) + LN_EPS);
#pragma unroll
            for (int j = 0; j < 4; ++j) { xv[r][j] = xv[r][j] * rstd * g1[j] + b1[j];
                *((f32x4*)(X1 + (size_t)(m + r) * D) + lane + 64 * j) = xv[r][j];
                u32x2 wv; wv.x = cvt_pk_bf16(xv[r][j].x, xv[r][j].y); wv.y = cvt_pk_bf16(xv[r][j].z, xv[r][j].w);
                *(u32x2*)(X1B + (size_t)(m + r) * D + 4 * lane + 256 * j) = wv; } }
        float gl[2][4];
#pragma unroll
        for (int e = 0; e < 4; ++e) { float s0 = 0.f, s1 = 0.f;
#pragma unroll
            for (int j = 0; j < 4; ++j) { const f32x4 wv = *(const LAS f32x4*)(WRG + e * 1024 + 256 * j + 4 * lane);
                s0 += xv[0][j].x * wv.x + xv[0][j].y * wv.y + xv[0][j].z * wv.z + xv[0][j].w * wv.w; s1 += xv[1][j].x * wv.x + xv[1][j].y * wv.y + xv[1][j].z * wv.z + xv[1][j].w * wv.w; }
            gl[0][e] = wave_sum(s0) + A.in[I_RBG][e]; gl[1][e] = wave_sum(s1) + A.in[I_RBG][e]; }
#pragma unroll
        for (int r = 0; r < 2; ++r) {
            int grp = 0; float gmax = gl[r][0];
#pragma unroll
            for (int e = 1; e < 4; ++e) if (gl[r][e] > gmax) { gmax = gl[r][e]; grp = e; }
            grp = __builtin_amdgcn_readfirstlane(grp);
            float gs = 0.f;
#pragma unroll
            for (int e = 0; e < 4; ++e) gs += __expf(gl[r][e] - gmax);
            const float pg = 1.0f / gs;
            float el[8];
#pragma unroll
            for (int e = 0; e < 8; ++e) { float s = 0.f;
#pragma unroll
                for (int j = 0; j < 4; ++j) { const f32x4 wv = *(const LAS f32x4*)(WRE + (grp * 8 + e) * 1024 + 256 * j + 4 * lane);
                    s += xv[r][j].x * wv.x + xv[r][j].y * wv.y + xv[r][j].z * wv.z + xv[r][j].w * wv.w; }
                el[e] = wave_sum(s) + A.in[I_RBE][grp * 8 + e]; }
            int i0 = 0; float m0 = el[0];
#pragma unroll
            for (int e = 1; e < 8; ++e) if (el[e] > m0) { m0 = el[e]; i0 = e; }
            int i1 = -1; float m1 = -3.0e38f;
#pragma unroll
            for (int e = 0; e < 8; ++e) if (e != i0 && el[e] > m1) { m1 = el[e]; i1 = e; }
            const float p1 = __expf(m1 - m0), inv = 1.0f / (1.0f + p1);
            if (lane == 0) { const int e0 = grp * 8 + i0, e1 = grp * 8 + i1;
                TOKE[(size_t)(m + r) * 2] = e0; TOKE[(size_t)(m + r) * 2 + 1] = e1; TOKW[(size_t)(m + r) * 2] = pg * inv; TOKW[(size_t)(m + r) * 2 + 1] = pg * p1 * inv;
                atomicAdd((int*)(HIST + e0), 1); atomicAdd((int*)(HIST + e1), 1); }
        }
    }
    __syncthreads();
    if (tid < 32) ((int*)F.ctl)[CW_WGCNT + F.vcu * 32 + tid] = HIST[tid];
}

DI void phase_dispatch(Frame& F, const Args& A) {
    LAS int* TOT = (LAS int*)(F.lds + LDSCTL_OFF + 256); LAS int* PB = TOT + 32; LAS int* POFF = TOT + 64; LAS int* CUR = TOT + 96;
    const int tid = F.tid; const int* WGC = (const int*)F.ctl + CW_WGCNT; const int* TOKE = wsp<int>(F, WS_TOKE); const float* TOKW = wsp<float>(F, WS_TOKW);
    int* row_tok = wsp<int>(F, WS_ROWS); float* row_w = (float*)(row_tok + MAXROWS); int* row_slot = row_tok + 2 * MAXROWS;
    __syncthreads();
    if (tid < 32) { int tot = 0, before = 0; for (int g = 0; g < F.G; ++g) { const int c = WGC[g * 32 + tid]; tot += c; before += (g < F.vcu) ? c : 0; } TOT[tid] = tot; PB[tid] = before; CUR[tid] = 0; }
    __syncthreads();
    if (tid == 0) { int po = 0; for (int e = 0; e < 32; ++e) { POFF[e] = po; if (F.vcu == 0) ((int*)F.ctl)[CW_TS + e] = po >> 8; po += (TOT[e] + 255) & ~255; } if (F.vcu == 0) ((int*)F.ctl)[CW_TS + 32] = po >> 8; }
    __syncthreads();
    const int TPW = NTOK / F.G;
    for (int a = tid; a < 2 * TPW; a += 512) { const int t = F.vcu * TPW + (a >> 1), k = a & 1; const int e = TOKE[(size_t)t * 2 + k];
        const int pos = POFF[e] + PB[e] + atomicAdd((int*)(CUR + e), 1);
        row_tok[pos] = t; row_w[pos] = TOKW[(size_t)t * 2 + k]; row_slot[pos] = 2 * t + k; }
    for (int e = F.vcu; e < 32; e += F.G) { const int lo = POFF[e] + TOT[e], hi = POFF[e] + ((TOT[e] + 255) & ~255);
        for (int r = lo + tid; r < hi; r += 512) { row_tok[r] = 0; row_w[r] = 0.f; row_slot[r] = -1; } }
}

DI void phase_final(Frame& F, const Args& A, int use_moe) {
    const int lane = F.lane; const int gw = F.vcu * NWAVES + F.wave, NGW = F.G * NWAVES;
    float* X1 = F.out; const bf16_t* SL = wsp<bf16_t>(F, WS_SLOTS);
    f32x4 g2[4], b2[4];
#pragma unroll
    for (int j = 0; j < 4; ++j) { g2[j] = *((const f32x4*)A.in[I_LN2G] + lane + 64 * j); b2[j] = *((const f32x4*)A.in[I_LN2B] + lane + 64 * j); }
    for (int m = gw; m < NTOK; m += NGW) {
        f32x4 v[4]; float s = 0.f;
#pragma unroll
        for (int j = 0; j < 4; ++j) { v[j] = *((const f32x4*)(X1 + (size_t)m * D) + lane + 64 * j) * DN_ALPHA;
            if (use_moe) { const u32x2 a = *(const u32x2*)(SL + (size_t)(2 * m) * D + 4 * lane + 256 * j), c = *(const u32x2*)(SL + (size_t)(2 * m + 1) * D + 4 * lane + 256 * j);
                v[j].x += bf_lo(a.x) + bf_lo(c.x); v[j].y += bf_hi(a.x) + bf_hi(c.x); v[j].z += bf_lo(a.y) + bf_lo(c.y); v[j].w += bf_hi(a.y) + bf_hi(c.y); }
            s += (v[j].x + v[j].y) + (v[j].z + v[j].w); }
        const float mean = wave_sum(s) * (1.f / D); float s2 = 0.f;
#pragma unroll
        for (int j = 0; j < 4; ++j) { v[j] = v[j] - mean; s2 += (v[j].x * v[j].x + v[j].y * v[j].y) + (v[j].z * v[j].z + v[j].w * v[j].w); }
        const float rstd = __builtin_amdgcn_rsqf(wave_sum(s2) * (1.f / D) + LN_EPS);
#pragma unroll
        for (int j = 0; j < 4; ++j) *((f32x4*)(X1 + (size_t)m * D) + lane + 64 * j) = v[j] * rstd * g2[j] + b2[j];
    }
}

constexpr int N_PHASES = 13;
__global__ void __launch_bounds__(NWAVES * 64, 2) fwd(Args args) {
    extern __shared__ __attribute__((aligned(16))) unsigned char lds[];
    Frame F;
    F.lds = (LAS unsigned char*)lds;
    F.tid = threadIdx.x; F.lane = F.tid & 63; F.wave = __builtin_amdgcn_readfirstlane(F.tid >> 6);
    F.G = gridDim.x; { const int bx = blockIdx.x; F.vcu = (F.G % 8 == 0) ? (bx % 8) * (F.G / 8) + bx / 8 : bx; }
    F.ws = args.ws; F.ctl = (unsigned*)(args.ws + WS_CTL); F.out = args.out;
    for (int u = F.tid; u < (LDS_BYTES - LDSCTL_OFF) / 4; u += NWAVES * 64) ((LAS unsigned*)(F.lds + LDSCTL_OFF))[u] = 0u;
    __syncthreads();
    const int lo = args.ph_lo, hi = args.ph_hi;
    XcdBarrier bar; bar.bar = F.ctl + CW_BAR; bar.x = 0; bar.st = nullptr;
    if (hi - lo > 1) bar = xcd_barrier_post(F.ctl + CW_BAR, (volatile LAS unsigned*)(F.lds + LDSCTL_OFF));
#define IN(k) (lo <= (k) && (k) < hi)
#define SEAM(k) do { if (IN(k) && IN((k) + 1)) xcd_barrier(bar); } while (0)
    LAS unsigned char* ring = F.lds;
    constexpr int ST = MK_STAGE;

    if (IN(0)) { if (ST >= 2) p0_prologue(F, args); } SEAM(0);
    if (IN(1)) { if (ST >= 2) {
        pg8::StaticOrder S; S.init(wsp<bf16_t>(F, WS_XB), wsp<bf16_t>(F, WS_WIN), NTOK, NPROJ, D, F.G, (int)blockIdx.x);
        EpiProj E{wsp<bf16_t>(F, WS_RX), wsp<bf16_t>(F, WS_RY), wsp<bf16_t>(F, WS_Q), wsp<bf16_t>(F, WS_K), wsp<bf16_t>(F, WS_V), wsp<bf16_t>(F, WS_G), (bf16_t*)F.out, (bf16_t*)F.out + (size_t)NTOK * D, args.in[I_BIN]};
        pg8::gemm_phase<EpiProj, pg8::StaticOrder, false, true, true>(ring, D, S, E); } } SEAM(1);
    if (IN(2)) { if (ST >= 3) phase_gla_pre(F, args); } SEAM(2);
    if (IN(3)) { if (ST >= 3) phase_gla_chain(F, args); } SEAM(3);
    if (IN(4)) { if (ST >= 3) phase_gla_fix(F, args); if (ST >= 2) phase_rnn_chain(F, args); } SEAM(4);
    if (IN(5)) { if (ST >= 2) {
        pg8::StaticOrder S; S.init(wsp<bf16_t>(F, WS_RY), wsp<bf16_t>(F, WS_WR), NTOK, D, D, F.G, (int)blockIdx.x);
        EpiMergeA E{(const bf16_t*)F.out, wsp<float>(F, WS_TMP)};
        pg8::gemm_phase<EpiMergeA, pg8::StaticOrder, false, true, true>(ring, D, S, E); } } SEAM(5);
    if (IN(6)) { if (ST >= 2) {
        pg8::StaticOrder S; S.init(wsp<bf16_t>(F, WS_G), wsp<bf16_t>(F, WS_WG), NTOK, D, D, F.G, (int)blockIdx.x);
        EpiMergeB E{(const bf16_t*)F.out + (size_t)NTOK * D, wsp<float>(F, WS_TMP), wsp<bf16_t>(F, WS_MERGED), ST >= 3 ? 1 : 0};
        pg8::gemm_phase<EpiMergeB, pg8::StaticOrder, false, true, true>(ring, D, S, E); } } SEAM(6);
    if (IN(7)) { if (ST >= 2) {
        pg8::StaticOrder S; S.init(wsp<bf16_t>(F, WS_MERGED), wsp<bf16_t>(F, WS_WO), NTOK, D, D, F.G, (int)blockIdx.x);
        EpiWo E{args.in[I_X], args.in[I_BO], F.out};
        pg8::gemm_phase<EpiWo, pg8::StaticOrder, false, true, true>(ring, D, S, E); } } SEAM(7);
    if (IN(8)) { if (ST >= 2) phase_ln1_router(F, args, F.out, 1.0f); else phase_ln1_router(F, args, args.in[I_X], DN_ALPHA); } SEAM(8);
    if (IN(9)) { if (ST >= 4) phase_dispatch(F, args); } SEAM(9);
    if (IN(10)) { if (ST >= 4) {
        LAS int* ts = (LAS int*)(F.lds + LDSCTL_OFF + 768);
        __syncthreads(); if (F.tid < 33) ts[F.tid] = ((const int*)F.ctl)[CW_TS + F.tid]; __syncthreads();
        MoeOrder S{(const char*)wsp<bf16_t>(F, WS_X1B), (const char*)wsp<bf16_t>(F, WS_E13), D, (size_t)1024 * 1024 * 2, ts, wsp<int>(F, WS_ROWS), F.G, (int)blockIdx.x, 1};
        EpiExp1 E{wsp<bf16_t>(F, WS_H)};
        pg8::gemm_phase<EpiExp1, MoeOrder, true, true, true>(ring, D, S, E); } } SEAM(10);
    if (IN(11)) { if (ST >= 4) {
        LAS int* ts = (LAS int*)(F.lds + LDSCTL_OFF + 768);
        __syncthreads(); if (F.tid < 33) ts[F.tid] = ((const int*)F.ctl)[CW_TS + F.tid]; __syncthreads();
        MoeOrder S{(const char*)wsp<bf16_t>(F, WS_H), (const char*)wsp<bf16_t>(F, WS_E2), FF, (size_t)1024 * 512 * 2, ts, wsp<int>(F, WS_ROWS), F.G, (int)blockIdx.x, 0};
        EpiExp2 E{wsp<int>(F, WS_ROWS) + 2 * MAXROWS, (const float*)(wsp<int>(F, WS_ROWS) + MAXROWS), wsp<bf16_t>(F, WS_SLOTS)};
        pg8::gemm_phase<EpiExp2, MoeOrder, false, true, true>(ring, FF, S, E); } } SEAM(11);
    if (IN(12)) phase_final(F, args, ST >= 4 ? 1 : 0);
#undef IN
#undef SEAM
}

extern "C" void kernel_launch(void* const* d_in, const int* in_sizes, int n_in, void* d_out, int out_size, void* d_ws, size_t ws_size, hipStream_t stream) {
    static int grid = 0;
    if (grid == 0) {
        if (n_in != 28 || in_sizes[0] != NTOK * D || out_size != NTOK * D || ws_size < WS_END) { fprintf(stderr, "kernel_launch: unexpected shapes (n_in %d, in0 %d, out %d, ws %zu); nothing launched\n", n_in, n_in > 0 ? in_sizes[0] : -1, out_size, ws_size); grid = -1; return; }
        int dev = 0, cus = 0, per_cu = 0;
        if (hipGetDevice(&dev) != hipSuccess || hipDeviceGetAttribute(&cus, hipDeviceAttributeMultiprocessorCount, dev) != hipSuccess) { grid = -1; return; }
        if (hipFuncSetAttribute((const void*)fwd, hipFuncAttributeMaxDynamicSharedMemorySize, LDS_BYTES) != hipSuccess) { fprintf(stderr, "kernel_launch: hipFuncSetAttribute failed\n"); grid = -1; return; }
        if (hipOccupancyMaxActiveBlocksPerMultiprocessor(&per_cu, (const void*)fwd, NWAVES * 64, LDS_BYTES) != hipSuccess || per_cu < 1) { fprintf(stderr, "kernel_launch: occupancy query reports %d workgroups per CU\n", per_cu); }
        (void)hipGetLastError();
        grid = cus;
        if (grid != 256) { fprintf(stderr, "kernel_launch: built for 256 CUs, found %d; nothing launched\n", cus); grid = -1; return; }
    }
    if (grid < 0) return;
    if (hipMemsetAsync((char*)d_ws + WS_CTL, 0, CTL_ZERO_BYTES, stream) != hipSuccess) return;
    Args a{};
    for (int i = 0; i < 28; ++i) a.in[i] = (const float*)d_in[i];
    a.out = (float*)d_out; a.ws = (unsigned char*)d_ws;
#if MK_ONE_LAUNCH
    a.ph_lo = 0; a.ph_hi = N_PHASES;
    hipLaunchKernelGGL(fwd, dim3(grid), dim3(NWAVES * 64), LDS_BYTES, stream, a);
#else
    for (int p = 0; p < N_PHASES; ++p) { a.ph_lo = p; a.ph_hi = p + 1; hipLaunchKernelGGL(fwd, dim3(grid), dim3(NWAVES * 64), LDS_BYTES, stream, a); }
#endif
}
```

```cpp
#include <hip/hip_runtime.h>
#include <cstdio>
#include <cstdint>

#ifndef MK_ONE_LAUNCH
#define MK_ONE_LAUNCH 1
#endif
#ifndef MK_DIAG
#define MK_DIAG -1
#endif
#ifndef MK_DUP
#define MK_DUP 0
#endif
#ifndef MK_STAGE
#define MK_STAGE 9
#endif

#define GAS __attribute__((address_space(1)))
#define LAS __attribute__((address_space(3)))
typedef unsigned short bf16_t;
typedef short bf16x8 __attribute__((ext_vector_type(8)));
typedef short s16x4 __attribute__((ext_vector_type(4)));
typedef float f32x4 __attribute__((ext_vector_type(4)));
typedef float f32x2 __attribute__((ext_vector_type(2)));
typedef unsigned u32x4 __attribute__((ext_vector_type(4)));
typedef unsigned u32x2 __attribute__((ext_vector_type(2)));
#define DI __device__ __forceinline__

typedef __bf16 bf16x2_t __attribute__((ext_vector_type(2)));
DI unsigned cvt_pk_bf16(float lo, float hi) { const f32x2 f = {lo, hi}; return __builtin_bit_cast(unsigned, __builtin_convertvector(f, bf16x2_t)); }
DI float bf_lo(unsigned u) { return __uint_as_float(u << 16); }
DI float bf_hi(unsigned u) { return __uint_as_float(u & 0xffff0000u); }
DI float bf2f(unsigned short b) { return __uint_as_float(((unsigned)b) << 16); }
DI unsigned short f2bf(float f) { return (unsigned short)(cvt_pk_bf16(f, 0.f) & 0xffffu); }
DI float fast_exp(float x) { return __builtin_amdgcn_exp2f(x * 1.4426950408889634f); }
DI float fast_rcp(float x) { return __builtin_amdgcn_rcpf(x); }
DI float sigmoid_f(float x) { return fast_rcp(1.0f + fast_exp(-x)); }
DI float silu_f(float x) { return x * sigmoid_f(x); }
DI float gelu_tanh_f(float x) {
    const float u = 1.5957691216057308f * (x + 0.044715f * x * x * x);
    return x * sigmoid_f(u);
}
#define LDS_WAIT() asm volatile("s_waitcnt lgkmcnt(0)" ::: "memory")
#define VM_WAIT() asm volatile("s_waitcnt vmcnt(0)" ::: "memory")
#define MFMA16(a, b, c) __builtin_amdgcn_mfma_f32_16x16x32_bf16((a), (b), (c), 0, 0, 0)

namespace pg8 {
#define PG8_LAS __attribute__((address_space(3)))
constexpr int BM = 256, BK = 64, HALF = 128, HTB = HALF * BK * 2  , STAGE_BYTES = 8 * HTB, NXCD = 8, WGM = 8;
__host__ __device__ __forceinline__ int lds_byte(int r, int c) { const int st = (r >> 4) * 2 + (c >> 5), rr = r & 15, cc = c & 31, ob = rr * 64 + cc * 2; return st * 1024 + (ob ^ (((ob >> 9) & 1) << 5)); }
__host__ __device__ __forceinline__ void stage_rc(int b, int& R, int& C) { const int st = b / 1024, sb = b % 1024, swz = sb ^ (((sb >> 9) & 1) << 5); R = (st >> 1) * 16 + swz / 64; C = (st & 1) * 32 + (swz % 64) / 2; }
__host__ __device__ __forceinline__ int perm32(int rho) { const int n = rho >> 4, i = rho & 15; return 8 * (i >> 2) + 4 * n + (i & 3); }

struct Unit { int pm, pn, e; };

struct StaticOrder {
    const char* A; const char* Bt; int K; int nM, nN, nwg, G, c;
    __device__ void init(const void* A_, const void* Bt_, int M, int N, int K_, int G_, int c_) { A = (const char*)A_; Bt = (const char*)Bt_; K = K_; nM = M / BM; nN = N / BM; nwg = nM * nN; G = G_; c = c_; }
    __device__ __forceinline__ bool next(int i, Unit& u) const {
        const long L = (long)i * G + c; if (L >= nwg) return false;
        int wgid = (int)L; { const int q = nwg / NXCD, r = nwg % NXCD, xcd = wgid % NXCD, off = wgid / NXCD; wgid = (xcd < r ? xcd * (q + 1) : r * (q + 1) + (xcd - r) * q) + off; }
        const int nig = WGM * nN, gid = wgid / nig, fm = gid * WGM, gsz = (nM - fm) < WGM ? (nM - fm) : WGM;
        u.pm = fm + ((wgid % nig) % gsz); u.pn = (wgid % nig) / gsz; u.e = i; return true;
    }
    __device__ __forceinline__ const char* a_ptr(const Unit& u) const { return A + (size_t)u.pm * BM * K * 2; }
    __device__ __forceinline__ const char* b_ptr(const Unit& u) const { return Bt + (size_t)u.pn * BM * K * 2; }
    __device__ __forceinline__ void a_rows(const Unit&, const int (&)[2], const int (&)[2], unsigned (&)[2][2]) const {}
};
struct NoHook { static constexpr bool ACTIVE = false; __device__ __forceinline__ bool wants(int) const { return false; }
    __device__ __forceinline__ void apply(int, f32x4 (&)[2][2][4][2], const Unit&, int, int, int, int) const {} };

template <class Epi, class Sched, class Hook, bool GATHER, bool ALIGN_EPI, bool SP2>
__device__ __forceinline__ void gemm_phase(PG8_LAS unsigned char* lds, const int K, const Sched& S, const Epi& E, const Hook& H) {
    const int tid = threadIdx.x, wid = __builtin_amdgcn_readfirstlane(tid >> 6), lane = tid & 63, wr = wid >> 2, wc = wid & 3, fr = lane & 15, fq = lane >> 4;
    const int nt = K / BK, lda = K;
    unsigned voffA[2], voffB[2]; int RA[2], CA[2];
#pragma unroll
    for (int i = 0; i < 2; ++i) { int R, C; stage_rc(tid * 16 + i * 8192, R, C); const int Rb = Epi::PERM ? ((R & ~31) + perm32(R & 31)) : R;
        RA[i] = R; CA[i] = C * 2; voffA[i] = (unsigned)(R * lda + C) * 2u; voffB[i] = (unsigned)(Rb * K + C) * 2u; }
    const size_t kstep = (size_t)(BK * 2);
    const size_t hstep = (size_t)HALF * K * 2, hstepA = (size_t)HALF * lda * 2;
    const unsigned ldsw = (unsigned)wid * 1024u;
    const int aoff = lds_byte(wr * 64 + fr, fq * 8), boff = lds_byte(wc * 32 + fr, fq * 8);
#define PG8_SA(b, h) (((b) * 2 + (h)) * HTB)
#define PG8_SB(b, h) ((4 + (b) * 2 + (h)) * HTB)
#define PG8_STAGE2(bufoff, gbase, v0, v1) do { \
        __builtin_amdgcn_global_load_lds((const unsigned*)((const char*)(gbase) + (v0)), (PG8_LAS unsigned*)(lds + (bufoff) + ldsw), 16, 0, 0); \
        __builtin_amdgcn_global_load_lds((const unsigned*)((const char*)(gbase) + (v1)), (PG8_LAS unsigned*)(lds + (bufoff) + ldsw + 8192), 16, 0, 0); } while (0)
#define PG8_STAGE(bufoff, gbase, voff) PG8_STAGE2(bufoff, gbase, (voff)[0], (voff)[1])
#define PG8_STAGE_A(bufoff, abase, h, NXT) do { if constexpr (GATHER) { PG8_STAGE2(bufoff, abase, (NXT) ? gN[h][0] : gC[h][0], (NXT) ? gN[h][1] : gC[h][1]); } else { PG8_STAGE(bufoff, (abase) + (h) * hstepA, voffA); } } while (0)
#define PG8_LDA(dst, b, h) do { _Pragma("unroll") for (int m = 0; m < 4; ++m) _Pragma("unroll") for (int k = 0; k < 2; ++k) dst[m][k] = *(const PG8_LAS bf16x8*)(lds + PG8_SA(b, h) + aoff + m * 2048 + k * 1024); } while (0)
#define PG8_LDB(dst, b, h) do { _Pragma("unroll") for (int n = 0; n < 2; ++n) _Pragma("unroll") for (int k = 0; k < 2; ++k) dst[n][k] = *(const PG8_LAS bf16x8*)(lds + PG8_SB(b, h) + boff + n * 2048 + k * 1024); } while (0)
#define PG8_MMA(ai, bj, At, Bt) do { __builtin_amdgcn_s_setprio(1); _Pragma("unroll") for (int m = 0; m < 4; ++m) _Pragma("unroll") for (int n = 0; n < 2; ++n) _Pragma("unroll") for (int k = 0; k < 2; ++k) \
        acc[ai][bj][m][n] = __builtin_amdgcn_mfma_f32_16x16x32_bf16(Bt[n][k], At[m][k], acc[ai][bj][m][n], 0, 0, 0); __builtin_amdgcn_s_setprio(0); } while (0)
#define PG8_WAIT_V(n) asm volatile("s_waitcnt vmcnt(" #n ")" ::: "memory")
#define PG8_WAIT_L(n) asm volatile("s_waitcnt lgkmcnt(" #n ")" ::: "memory")
#define PG8_BAR __builtin_amdgcn_s_barrier()
#define PG8_SCHED __builtin_amdgcn_sched_barrier(0)
    Unit cur, nxt; int ui = 0;
    if (!S.next(0, cur)) return;
    f32x4 acc[2][2][4][2];
#pragma unroll
    for (int a = 0; a < 2; ++a)
#pragma unroll
        for (int b = 0; b < 2; ++b)
#pragma unroll
            for (int m = 0; m < 4; ++m)
#pragma unroll
                for (int n = 0; n < 2; ++n) acc[a][b][m][n] = (f32x4){0.f, 0.f, 0.f, 0.f};
    bf16x8 At[4][2], B0[2][2], B1[2][2];
    unsigned gC[2][2] = {{0u, 0u}, {0u, 0u}}, gN[2][2] = {{0u, 0u}, {0u, 0u}};
    const char* cA = S.a_ptr(cur); const char* cB = S.b_ptr(cur);
    if constexpr (GATHER) S.a_rows(cur, RA, CA, gC);
    if constexpr (SP2) {
        PG8_STAGE(PG8_SB(0, 0), cB, voffB); PG8_STAGE(PG8_SB(0, 1), cB + hstep, voffB); PG8_STAGE_A(PG8_SA(0, 0), cA, 0, false); PG8_STAGE_A(PG8_SA(0, 1), cA, 1, false);
        if (wr == 1) PG8_BAR;
        PG8_WAIT_V(2); PG8_BAR;
        PG8_STAGE(PG8_SB(1, 0), cB + kstep, voffB); PG8_STAGE_A(PG8_SA(1, 0), cA + kstep, 0, false); PG8_STAGE(PG8_SB(1, 1), cB + hstep + kstep, voffB);
        PG8_WAIT_V(6); PG8_BAR;
    } else {
        PG8_STAGE(PG8_SB(0, 0), cB, voffB); PG8_STAGE_A(PG8_SA(0, 0), cA, 0, false); PG8_STAGE(PG8_SB(0, 1), cB + hstep, voffB); PG8_STAGE_A(PG8_SA(0, 1), cA, 1, false);
        if (wr == 1) PG8_BAR;
        PG8_WAIT_V(4); PG8_BAR;
        PG8_STAGE(PG8_SB(1, 0), cB + kstep, voffB); PG8_STAGE_A(PG8_SA(1, 0), cA + kstep, 0, false); PG8_STAGE(PG8_SB(1, 1), cB + hstep + kstep, voffB);
        PG8_WAIT_V(6); PG8_BAR;
    }
    for (;;) {
        const bool has_next = S.next(ui + 1, nxt);
        const char* nA = has_next ? S.a_ptr(nxt) : cA; const char* nB = has_next ? S.b_ptr(nxt) : cB;
        if constexpr (GATHER) { if (has_next) S.a_rows(nxt, RA, CA, gN); else {
#pragma unroll
            for (int h = 0; h < 2; ++h) { gN[h][0] = gC[h][0]; gN[h][1] = gC[h][1]; } } }
        for (int t = 0; t < nt; t += 2) {
            const bool last = (t == nt - 2);
            const char* a1 = cA + (size_t)(t + 1) * kstep;
            const char* a2 = last ? nA : cA + (size_t)(t + 2) * kstep; const char* b2 = last ? nB : cB + (size_t)(t + 2) * kstep;
            const char* a3 = a2 + kstep; const char* b3 = b2 + kstep;
            if constexpr (Hook::ACTIVE) { if (H.wants(t)) H.apply(t, acc, cur, wr, wc, fr, fq); }
            if constexpr (SP2) {
            PG8_LDB(B0, 0, 0); PG8_LDB(B1, 0, 1); PG8_SCHED; PG8_LDA(At, 0, 0); PG8_STAGE_A(PG8_SA(1, 1), a1, 1, false);
            PG8_WAIT_V(8); PG8_WAIT_L(0); PG8_BAR; PG8_MMA(0, 0, At, B0); PG8_MMA(0, 1, At, B1); PG8_BAR; PG8_SCHED;
            PG8_LDA(At, 0, 1); PG8_STAGE(PG8_SB(0, 0), b2, voffB); PG8_STAGE(PG8_SB(0, 1), b2 + hstep, voffB); PG8_STAGE_A(PG8_SA(0, 0), a2, 0, last);
            PG8_WAIT_V(8); PG8_WAIT_L(0); PG8_BAR; PG8_MMA(1, 0, At, B0); PG8_MMA(1, 1, At, B1); PG8_BAR; PG8_SCHED;
            PG8_LDB(B0, 1, 0); PG8_LDB(B1, 1, 1); PG8_SCHED; PG8_LDA(At, 1, 0); PG8_STAGE_A(PG8_SA(0, 1), a2, 1, last);
            PG8_WAIT_V(8); PG8_WAIT_L(0); PG8_BAR; PG8_MMA(0, 0, At, B0); PG8_MMA(0, 1, At, B1); PG8_BAR; PG8_SCHED;
            PG8_LDA(At, 1, 1); PG8_STAGE(PG8_SB(1, 0), b3, voffB); PG8_STAGE(PG8_SB(1, 1), b3 + hstep, voffB); PG8_STAGE_A(PG8_SA(1, 0), a3, 0, last);
            PG8_WAIT_V(8); PG8_WAIT_L(0); PG8_BAR; PG8_MMA(1, 0, At, B0); PG8_MMA(1, 1, At, B1); PG8_BAR; PG8_SCHED;
            } else {
            PG8_LDB(B0, 0, 0); PG8_SCHED; PG8_LDA(At, 0, 0); PG8_STAGE_A(PG8_SA(1, 1), a1, 1, false);
            PG8_WAIT_L(8); PG8_BAR; PG8_WAIT_L(0); PG8_MMA(0, 0, At, B0); PG8_BAR; PG8_SCHED;
            PG8_LDB(B1, 0, 1); PG8_STAGE(PG8_SB(0, 0), b2, voffB);
            PG8_BAR; PG8_WAIT_L(0); PG8_MMA(0, 1, At, B1); PG8_BAR;
            PG8_LDA(At, 0, 1); PG8_STAGE_A(PG8_SA(0, 0), a2, 0, last);
            PG8_BAR; PG8_WAIT_L(0); PG8_MMA(1, 0, At, B0); PG8_BAR; PG8_SCHED;
            PG8_STAGE(PG8_SB(0, 1), b2 + hstep, voffB);
            PG8_WAIT_V(6); PG8_BAR; PG8_MMA(1, 1, At, B1); PG8_BAR;
            PG8_LDB(B0, 1, 0); PG8_SCHED; PG8_LDA(At, 1, 0); PG8_STAGE_A(PG8_SA(0, 1), a2, 1, last);
            PG8_WAIT_L(8); PG8_BAR; PG8_WAIT_L(0); PG8_MMA(0, 0, At, B0); PG8_BAR; PG8_SCHED;
            PG8_LDB(B1, 1, 1); PG8_STAGE(PG8_SB(1, 0), b3, voffB);
            PG8_BAR; PG8_WAIT_L(0); PG8_MMA(0, 1, At, B1); PG8_BAR;
            PG8_LDA(At, 1, 1); PG8_STAGE_A(PG8_SA(1, 0), a3, 0, last);
            PG8_BAR; PG8_WAIT_L(0); PG8_MMA(1, 0, At, B0); PG8_BAR; PG8_SCHED;
            PG8_STAGE(PG8_SB(1, 1), b3 + hstep, voffB);
            PG8_WAIT_V(6); PG8_BAR; PG8_MMA(1, 1, At, B1); PG8_BAR;
            }
        }
        if constexpr (ALIGN_EPI) { if (wr == 0) PG8_BAR; }
        E(acc, cur, wr, wc, fr, fq);
        if (!has_next) break;
#pragma unroll
        for (int a = 0; a < 2; ++a)
#pragma unroll
            for (int b = 0; b < 2; ++b)
#pragma unroll
                for (int m = 0; m < 4; ++m)
#pragma unroll
                    for (int n = 0; n < 2; ++n) acc[a][b][m][n] = (f32x4){0.f, 0.f, 0.f, 0.f};
        cur = nxt; cA = nA; cB = nB; ++ui;
        if constexpr (GATHER) {
#pragma unroll
            for (int h = 0; h < 2; ++h) { gC[h][0] = gN[h][0]; gC[h][1] = gN[h][1]; } }
        if constexpr (ALIGN_EPI) { if (wr == 1) PG8_BAR; }
    }
    PG8_WAIT_V(0);
    if constexpr (!ALIGN_EPI) { if (wr == 0) PG8_BAR; }
    PG8_BAR;
#undef PG8_SA
#undef PG8_SB
#undef PG8_STAGE
#undef PG8_STAGE2
#undef PG8_STAGE_A
#undef PG8_LDA
#undef PG8_LDB
#undef PG8_MMA
#undef PG8_WAIT_V
#undef PG8_WAIT_L
#undef PG8_BAR
#undef PG8_SCHED
}
}

constexpr int NB = 16, SEQ = 2048, D = 1024, NTOK = NB * SEQ;
constexpr int IN_COLS = 7184, NPROJ = 7168, ALR_COL = 5120;
constexpr int NEXP = 32, FF = 512, NWAVES = 8;
constexpr float DN_ALPHA = 1.189207115002721f, LN_EPS = 1e-5f, RMS_EPS = 1e-6f, QSCALE = 0.08838834764831845f;
constexpr int MAXROWS = 2 * NTOK + NEXP * 256;

constexpr size_t MiB = 1u << 20;
constexpr size_t WS_CTL = 0, CTL_ZERO_BYTES = 1 * MiB;
constexpr size_t WS_RGT = 1 * MiB;
constexpr size_t WS_TOKE = 1 * MiB + 512 * 1024;
constexpr size_t WS_TOKW = WS_TOKE + 256 * 1024;
constexpr size_t WS_ALR = 2 * MiB;
constexpr size_t WS_WR = 4 * MiB, WS_WG = 6 * MiB, WS_WO = 8 * MiB;
constexpr size_t WS_RX = 10 * MiB, WS_RY = 74 * MiB, WS_Q = 138 * MiB, WS_K = 170 * MiB, WS_V = 202 * MiB, WS_G = 266 * MiB;
constexpr size_t WS_E13 = 330 * MiB, WS_E2 = 394 * MiB;
constexpr size_t WS_WIN = 426 * MiB, WS_XB = 440 * MiB;
constexpr size_t WS_ORAW = 426 * MiB, WS_PBUF = 490 * MiB, WS_DEC = 506 * MiB, WS_SSQ = 507 * MiB;
constexpr size_t WS_ROWS = 511 * MiB;
constexpr size_t WS_MERGED = 426 * MiB;
constexpr size_t WS_TMP = 138 * MiB;
constexpr size_t WS_X1B = 10 * MiB;
constexpr size_t WS_H = 74 * MiB;
constexpr size_t WS_SLOTS = 146 * MiB;
constexpr size_t WS_END = 512 * MiB;
static_assert(WS_H + (size_t)MAXROWS * FF * 2 <= WS_SLOTS && WS_SLOTS + (size_t)2 * NTOK * D * 2 <= WS_E13 && WS_ROWS + 3 * (size_t)MAXROWS * 4 <= WS_END, "d_ws map");
constexpr int CW_BAR = 4096;
constexpr int CW_TS = 8192;
constexpr int CW_WGCNT = 131072;

constexpr int RING_BYTES = 131072, AUX_OFF = 131072, LDSCTL_OFF = 147456, LDS_BYTES = 148480;

#define XB_TMO      128
#define XB_XCNT(j)  (256  + 64 * (j))
#define XB_XSUB(j)  (1280 + 64 * (j))
#define XB_XGEN(j)  (2304 + 64 * (j))
#define XB_TOP      3328
#define XB_TOPGEN   3392
#define XCD_BAR_WORDS 3456
#define XB_SPIN_CAP (1u << 18)
__device__ __forceinline__ unsigned xb_ld(unsigned* p)              { return __hip_atomic_load(p, __ATOMIC_RELAXED, __HIP_MEMORY_SCOPE_AGENT); }
__device__ __forceinline__ unsigned xb_add(unsigned* p, unsigned v) { return __hip_atomic_fetch_add(p, v, __ATOMIC_RELAXED, __HIP_MEMORY_SCOPE_AGENT); }
__device__ __forceinline__ unsigned xb_xcc_id() { return (unsigned)__builtin_amdgcn_s_getreg((3 << 11) | 20) & 0xFu; }
#define XB_SPIN(cond, bar) do { unsigned _sp = 0; while (cond) { __builtin_amdgcn_s_sleep(1); \
    if ((++_sp & 255u) == 0u) { if (xb_ld(&(bar)[XB_TMO])) break; if (_sp > XB_SPIN_CAP) { atomicAdd(&(bar)[XB_TMO], 1u); break; } } } } while (0)
struct XcdBarrier { unsigned* bar; unsigned x; volatile LAS unsigned* st; };
__device__ __forceinline__ XcdBarrier xcd_barrier_post(unsigned* bar, volatile LAS unsigned* st) {
    XcdBarrier b; b.bar = bar; b.x = xb_xcc_id(); b.st = st;
    if (threadIdx.x == 0) (void)xb_add(&bar[XB_XCNT(b.x)], 1u);
    return b;
}
__device__ __forceinline__ void xcd_barrier_complete(unsigned* bar, unsigned x, unsigned& nloc, unsigned& nx) {
    const unsigned G = gridDim.x * gridDim.y * gridDim.z;
    unsigned sum, cnt, mine, sp = 0u;
    for (;;) {
        sum = 0u; cnt = 0u; mine = 0u;
#pragma unroll
        for (unsigned j = 0; j < 16; ++j) { const unsigned c = xb_ld(&bar[XB_XCNT(j)]); sum += c; cnt += (c > 0u) ? 1u : 0u; mine = (j == x) ? c : mine; }
        if (sum == G) break;
        __builtin_amdgcn_s_sleep(1);
        if ((++sp & 255u) == 0u) { if (xb_ld(&bar[XB_TMO])) break; if (sp > XB_SPIN_CAP) { atomicAdd(&bar[XB_TMO], 1u); break; } }
    }
    nloc = mine > 0u ? mine : 1u; nx = cnt > 0u ? cnt : 1u;
}
__device__ __forceinline__ void xcd_barrier(const XcdBarrier& b) {
    asm volatile("s_waitcnt vmcnt(0)" ::: "memory");
    __syncthreads();
    if (threadIdx.x == 0) {
        unsigned* bar = b.bar;
        __builtin_amdgcn_s_waitcnt(0);
        unsigned nloc = b.st[0], nx = b.st[1];
        if (nloc == 0u) { xcd_barrier_complete(bar, b.x, nloc, nx); b.st[0] = nloc; b.st[1] = nx; }
        const unsigned old = xb_add(&bar[XB_XSUB(b.x)], 1u);
        const unsigned gen = old / nloc;
        if (old + 1u == (gen + 1u) * nloc) {
            __builtin_amdgcn_fence(__ATOMIC_RELEASE, "agent");
            asm volatile("s_waitcnt vmcnt(0)" ::: "memory");
            const unsigned og = xb_add(&bar[XB_TOP], 1u);
            const unsigned tg = og / nx;
            if (og + 1u == (tg + 1u) * nx) xb_add(&bar[XB_TOPGEN], 1u);
            else XB_SPIN(xb_ld(&bar[XB_TOPGEN]) == tg, bar);
            __builtin_amdgcn_fence(__ATOMIC_ACQUIRE, "agent");
            xb_add(&bar[XB_XGEN(b.x)], 1u);
            asm volatile("s_waitcnt vmcnt(0)" ::: "memory");
        } else {
            XB_SPIN(xb_ld(&bar[XB_XGEN(b.x)]) == gen, bar);
            __builtin_amdgcn_fence(__ATOMIC_ACQUIRE, "agent");
            asm volatile("s_waitcnt vmcnt(0)" ::: "memory");
        }
    }
    __syncthreads();
}

struct Frame {
    LAS unsigned char* lds;
    unsigned* ctl;
    int tid, lane, wave, vcu, G;
    float* out;
    unsigned char* ws;
};
struct Args { const float* in[28]; float* out; unsigned char* ws; int ph_lo, ph_hi, dup, pad; };
enum InIdx { I_X = 0, I_WIN, I_BIN, I_CONVW, I_CONVB, I_RGWA, I_RGBA, I_RGWX, I_RGBX, I_LAM, I_GWA2, I_GBA, I_GNORM, I_WPR, I_WPG, I_WO, I_BO, I_LN1G, I_LN1B,
             I_RWG, I_RBG, I_RWE, I_RBE, I_EW1, I_EW3, I_EW2, I_LN2G, I_LN2B };
template <class T> DI T* wsp(Frame& F, size_t off) { return (T*)(F.ws + off); }

DI float wave_sum(float v) {
#pragma unroll
    for (int o = 1; o < 64; o <<= 1) v += __shfl_xor(v, o);
    return v;
}
DI int idx16(int lane) { return ((lane >> 5) & 1) * 8 + ((lane >> 4) & 1) * 4 + ((lane >> 3) & 1) * 2 + ((lane >> 2) & 1); }
DI float reduce16(const float (&a)[16], int lane) {
    float b[8], c[4], d[2];
    { const bool hi = (lane & 32) != 0;
#pragma unroll
      for (int i = 0; i < 8; ++i) { const float keep = hi ? a[i + 8] : a[i], send = hi ? a[i] : a[i + 8]; b[i] = keep + __shfl_xor(send, 32); } }
    { const bool hi = (lane & 16) != 0;
#pragma unroll
      for (int i = 0; i < 4; ++i) { const float keep = hi ? b[i + 4] : b[i], send = hi ? b[i] : b[i + 4]; c[i] = keep + __shfl_xor(send, 16); } }
    { const bool hi = (lane & 8) != 0;
#pragma unroll
      for (int i = 0; i < 2; ++i) { const float keep = hi ? c[i + 2] : c[i], send = hi ? c[i] : c[i + 2]; d[i] = keep + __shfl_xor(send, 8); } }
    float e; { const bool hi = (lane & 4) != 0; const float keep = hi ? d[1] : d[0], send = hi ? d[0] : d[1]; e = keep + __shfl_xor(send, 4); }
    e += __shfl_xor(e, 2); e += __shfl_xor(e, 1);
    return e;
}

DI void transpose_item(const float* src, int ld_src, bf16_t* dst, int ld_dst, LAS float* scr, int lane) {
    f32x4 v[8];
#pragma unroll
    for (int i = 0; i < 8; ++i) v[i] = *(const f32x4*)(src + (size_t)((lane >> 3) + 8 * i) * ld_src + 4 * (lane & 7));
#pragma unroll
    for (int i = 0; i < 8; ++i) { LAS float* p = scr + ((lane >> 3) + 8 * i) * 33 + 4 * (lane & 7); p[0] = v[i].x; p[1] = v[i].y; p[2] = v[i].z; p[3] = v[i].w; }
    LDS_WAIT(); asm volatile("" ::: "memory");
    const int c = lane & 7;
#pragma unroll
    for (int j = 0; j < 4; ++j) { const int n = (lane >> 3) + 8 * j; const LAS float* s = scr + (8 * c) * 33 + n;
        u32x4 o; o.x = cvt_pk_bf16(s[0 * 33], s[1 * 33]); o.y = cvt_pk_bf16(s[2 * 33], s[3 * 33]); o.z = cvt_pk_bf16(s[4 * 33], s[5 * 33]); o.w = cvt_pk_bf16(s[6 * 33], s[7 * 33]);
        *(u32x4*)(dst + (size_t)n * ld_dst + 8 * c) = o; }
    LDS_WAIT(); asm volatile("" ::: "memory");
}
DI void p0_prologue(Frame& F, const Args& A) {
    LAS float* scr = (LAS float*)(F.lds + F.wave * 8704);
    LAS float* walr = (LAS float*)(F.lds + 81920);
    const int gw = F.vcu * NWAVES + F.wave, NGW = F.G * NWAVES, lane = F.lane;
    const float* w_in = A.in[I_WIN];
    for (int i = F.tid; i < 16 * 1024; i += NWAVES * 64) { const int k = i >> 4, r = i & 15; walr[r * 1024 + k] = w_in[(size_t)k * IN_COLS + ALR_COL + r]; }
    __syncthreads();
    constexpr int N_WIN = 16 * 224, N_SQ = 3 * 512, N_RG = 128, N_E13 = 32 * 512, N_E2 = 32 * 256;
    constexpr int NITEMS = N_WIN + N_SQ + N_RG + N_E13 + N_E2;
    for (int rep_ = 0; rep_ < 1 + ((MK_DUP >> 13) & 1); ++rep_)
    for (int it0 = gw; it0 < NITEMS; it0 += NGW) {
        int it = it0;
        if (it < N_WIN) { const int kb = it / 224, nb = it % 224, n0 = 32 * nb, sc = n0 + (n0 >= ALR_COL ? 16 : 0);
            transpose_item(w_in + (size_t)(64 * kb) * IN_COLS + sc, IN_COLS, wsp<bf16_t>(F, WS_WIN) + (size_t)n0 * 1024 + 64 * kb, 1024, scr, lane); continue; }
        it -= N_WIN;
        if (it < N_SQ) { const int mat = it / 512, r = it % 512, kb = r / 32, nb = r % 32;
            const size_t so = (size_t)(64 * kb) * 1024 + 32 * nb, dof = (size_t)(32 * nb) * 1024 + 64 * kb;
            if (mat == 0) transpose_item(A.in[I_WPR] + so, 1024, wsp<bf16_t>(F, WS_WR) + dof, 1024, scr, lane);
            else if (mat == 1) transpose_item(A.in[I_WPG] + so, 1024, wsp<bf16_t>(F, WS_WG) + dof, 1024, scr, lane);
            else transpose_item(A.in[I_WO] + so, 1024, wsp<bf16_t>(F, WS_WO) + dof, 1024, scr, lane);
            continue; }
        it -= N_SQ;
        if (it < N_RG) { const int bg = it / 8, r = it % 8, kb = r / 4, nb = r % 4, blk = bg >> 1, gate = bg & 1;
            const size_t so = (size_t)blk * 16384 + (64 * kb) * 128 + 32 * nb; bf16_t* dp = wsp<bf16_t>(F, WS_RGT) + (size_t)bg * 16384 + (32 * nb) * 128 + 64 * kb;
            if (gate) transpose_item(A.in[I_RGWX] + so, 128, dp, 128, scr, lane); else transpose_item(A.in[I_RGWA] + so, 128, dp, 128, scr, lane);
            continue; }
        it -= N_RG;
        if (it < N_E13) { const int e = it / 512, r = it % 512, which = r / 256, r2 = r % 256, kb = r2 / 16, nb = r2 % 16, n0 = 32 * nb;
            const int nd = 256 * (n0 / 128) + 128 * which + (n0 % 128);
            const size_t so = (size_t)e * (1024 * 512) + (size_t)(64 * kb) * 512 + n0; bf16_t* dp = wsp<bf16_t>(F, WS_E13) + (size_t)e * (1024 * 1024) + (size_t)nd * 1024 + 64 * kb;
            if (which) transpose_item(A.in[I_EW3] + so, 512, dp, 1024, scr, lane); else transpose_item(A.in[I_EW1] + so, 512, dp, 1024, scr, lane);
            continue; }
        it -= N_E13;
        { const int e = it / 256, r = it % 256, kb = r / 32, nb = r % 32;
            const float* W = A.in[I_EW2] + (size_t)e * (512 * 1024);
            transpose_item(W + (size_t)(64 * kb) * 1024 + 32 * nb, 1024, wsp<bf16_t>(F, WS_E2) + (size_t)e * (1024 * 512) + (size_t)(32 * nb) * 512 + 64 * kb, 512, scr, lane); }
    }
    const float* x = A.in[I_X]; bf16_t* xb = wsp<bf16_t>(F, WS_XB); float* alr = wsp<float>(F, WS_ALR);
    const float balr = A.in[I_BIN][ALR_COL + idx16(lane)];
    for (int rep_ = 0; rep_ < 1 + ((MK_DUP >> 14) & 1); ++rep_)
    for (int m = 2 * gw; m < NTOK; m += 2 * NGW) {
        f32x4 xv[2][4];
#pragma unroll
        for (int r = 0; r < 2; ++r)
#pragma unroll
            for (int j = 0; j < 4; ++j) xv[r][j] = *((const f32x4*)(x + (size_t)(m + r) * D) + lane + 64 * j);
#pragma unroll
        for (int r = 0; r < 2; ++r)
#pragma unroll
            for (int j = 0; j < 4; ++j) { u32x2 w; w.x = cvt_pk_bf16(xv[r][j].x, xv[r][j].y); w.y = cvt_pk_bf16(xv[r][j].z, xv[r][j].w);
                *(u32x2*)(xb + (size_t)(m + r) * D + 4 * lane + 256 * j) = w; }
        float a0[16], a1[16];
#pragma unroll
        for (int rr = 0; rr < 16; ++rr) { a0[rr] = 0.f; a1[rr] = 0.f; }
#pragma unroll
        for (int j = 0; j < 4; ++j) {
#pragma unroll
            for (int rr = 0; rr < 16; ++rr) { const f32x4 wv = *(const LAS f32x4*)(walr + rr * 1024 + 256 * j + 4 * lane);
                a0[rr] += xv[0][j].x * wv.x + xv[0][j].y * wv.y + xv[0][j].z * wv.z + xv[0][j].w * wv.w;
                a1[rr] += xv[1][j].x * wv.x + xv[1][j].y * wv.y + xv[1][j].z * wv.z + xv[1][j].w * wv.w; }
            __builtin_amdgcn_sched_barrier(0); }
        const float t0 = reduce16(a0, lane) + balr, t1 = reduce16(a1, lane) + balr;
        if ((lane & 3) == 0) { alr[(size_t)m * 16 + idx16(lane)] = t0; alr[(size_t)(m + 1) * 16 + idx16(lane)] = t1; }
    }
}

using pg8::Unit;
struct EpiProj {
    static constexpr bool PERM = true;
    bf16_t *rx, *ry, *q, *k, *v, *g, *ga, *gb; const float* bias;
    DI void operator()(const f32x4 (&acc)[2][2][4][2], const Unit& u, int wr, int wc, int fr, int fq) const {
        const int pn = u.pn; bf16_t* base; int ldc = 1024, ct;
        if (pn < 4) { base = rx; ct = pn; } else if (pn < 8) { base = ry; ct = pn - 4; } else if (pn < 10) { base = q; ldc = 512; ct = pn - 8; } else if (pn < 12) { base = k; ldc = 512; ct = pn - 10; }
        else if (pn < 16) { base = v; ct = pn - 12; } else if (pn < 20) { base = g; ct = pn - 16; } else if (pn < 24) { base = ga; ct = pn - 20; } else { base = gb; ct = pn - 24; }
        const int row0 = u.pm * 256 + wr * 64 + fr, col0 = ct * 256 + wc * 32 + 8 * fq, bcol0 = pn * 256 + (pn >= 20 ? 16 : 0) + wc * 32 + 8 * fq;
        f32x4 bv[2][2];
#pragma unroll
        for (int bj = 0; bj < 2; ++bj)
#pragma unroll
            for (int n = 0; n < 2; ++n) bv[bj][n] = *(const f32x4*)(bias + bcol0 + bj * 128 + 4 * n);
#pragma unroll
        for (int ai = 0; ai < 2; ++ai)
#pragma unroll
            for (int m = 0; m < 4; ++m) { bf16_t* rowp = base + (size_t)(row0 + ai * 128 + m * 16) * ldc + col0;
#pragma unroll
                for (int bj = 0; bj < 2; ++bj) { const f32x4 v0 = acc[ai][bj][m][0] + bv[bj][0], v1 = acc[ai][bj][m][1] + bv[bj][1];
                    u32x4 w; w.x = cvt_pk_bf16(v0[0], v0[1]); w.y = cvt_pk_bf16(v0[2], v0[3]); w.z = cvt_pk_bf16(v1[0], v1[1]); w.w = cvt_pk_bf16(v1[2], v1[3]);
                    *(u32x4*)(rowp + bj * 128) = w; } }
    }
};
DI void unpack8(const u32x4 w, float (&f)[8]) { f[0] = bf_lo(w.x); f[1] = bf_hi(w.x); f[2] = bf_lo(w.y); f[3] = bf_hi(w.y); f[4] = bf_lo(w.z); f[5] = bf_hi(w.z); f[6] = bf_lo(w.w); f[7] = bf_hi(w.w); }
struct EpiMergeA {
    static constexpr bool PERM = true;
    const bf16_t* ga; bf16_t* tmp;
    DI void operator()(const f32x4 (&acc)[2][2][4][2], const Unit& u, int wr, int wc, int fr, int fq) const {
        const int row0 = u.pm * 256 + wr * 64 + fr, col0 = u.pn * 256 + wc * 32 + 8 * fq;
#pragma unroll
        for (int ai = 0; ai < 2; ++ai)
#pragma unroll
            for (int m = 0; m < 4; ++m) { const size_t off = (size_t)(row0 + ai * 128 + m * 16) * D + col0;
#pragma unroll
                for (int bj = 0; bj < 2; ++bj) { float gf[8]; unpack8(*(const u32x4*)(ga + off + bj * 128), gf);
                    f32x4 o0, o1;
#pragma unroll
                    for (int j = 0; j < 4; ++j) { o0[j] = sigmoid_f(gf[j]) * acc[ai][bj][m][0][j]; o1[j] = sigmoid_f(gf[4 + j]) * acc[ai][bj][m][1][j]; }
                    u32x4 w; w.x = cvt_pk_bf16(o0[0], o0[1]); w.y = cvt_pk_bf16(o0[2], o0[3]); w.z = cvt_pk_bf16(o1[0], o1[1]); w.w = cvt_pk_bf16(o1[2], o1[3]);
                    *(u32x4*)(tmp + off + bj * 128) = w; } }
    }
};
struct RowHook { static constexpr bool ACTIVE = true;
    const LAS float* rs;
    DI bool wants(int t) const { return t == 4 || t == 8 || t == 12; }
    DI void apply(int t, f32x4 (&acc)[2][2][4][2], const Unit& u, int wr, int wc, int fr, int fq) const {
        const int h = t >> 2;
#pragma unroll
        for (int ai = 0; ai < 2; ++ai)
#pragma unroll
            for (int m = 0; m < 4; ++m) { const f32x4 r4 = *(const LAS f32x4*)(rs + ((u.e & 1) * 256 + ai * 128 + wr * 64 + m * 16 + fr) * 4);
                const float f = (h == 1 ? r4[0] : (h == 2 ? r4[1] : r4[2])) * fast_rcp(h == 1 ? r4[1] : (h == 2 ? r4[2] : r4[3]));
#pragma unroll
                for (int bj = 0; bj < 2; ++bj) { acc[ai][bj][m][0] = acc[ai][bj][m][0] * f; acc[ai][bj][m][1] = acc[ai][bj][m][1] * f; } }
    }
};
struct EpiMergeB {
    static constexpr bool PERM = true;
    const bf16_t* gb; const bf16_t* tmp; bf16_t* merged; const LAS float* rs;
    DI void operator()(const f32x4 (&acc)[2][2][4][2], const Unit& u, int wr, int wc, int fr, int fq) const {
        const int row0 = u.pm * 256 + wr * 64 + fr, col0 = u.pn * 256 + wc * 32 + 8 * fq;
#pragma unroll
        for (int ai = 0; ai < 2; ++ai)
#pragma unroll
            for (int m = 0; m < 4; ++m) { const size_t off = (size_t)(row0 + ai * 128 + m * 16) * D + col0; const float rl = rs[((u.e & 1) * 256 + ai * 128 + wr * 64 + m * 16 + fr) * 4 + 3];
#pragma unroll
                for (int bj = 0; bj < 2; ++bj) { float gf[8], tf[8]; unpack8(*(const u32x4*)(gb + off + bj * 128), gf); unpack8(*(const u32x4*)(tmp + off + bj * 128), tf);
                    f32x4 o0, o1;
#pragma unroll
                    for (int j = 0; j < 4; ++j) { o0[j] = tf[j] + acc[ai][bj][m][0][j] * sigmoid_f(gf[j]) * rl; o1[j] = tf[4 + j] + acc[ai][bj][m][1][j] * sigmoid_f(gf[4 + j]) * rl; }
                    u32x4 w; w.x = cvt_pk_bf16(o0[0], o0[1]); w.y = cvt_pk_bf16(o0[2], o0[3]); w.z = cvt_pk_bf16(o1[0], o1[1]); w.w = cvt_pk_bf16(o1[2], o1[3]);
                    *(u32x4*)(merged + off + bj * 128) = w; } }
    }
};
struct EpiWo {
    static constexpr bool PERM = false;
    const float* x; const float* bo; float* z;
    DI void operator()(const f32x4 (&acc)[2][2][4][2], const Unit& u, int wr, int wc, int fr, int fq) const {
        const int row0 = u.pm * 256 + wr * 64 + fr, col0 = u.pn * 256 + wc * 32 + 4 * fq;
        f32x4 bv[2][2];
#pragma unroll
        for (int bj = 0; bj < 2; ++bj)
#pragma unroll
            for (int n = 0; n < 2; ++n) bv[bj][n] = *(const f32x4*)(bo + col0 + bj * 128 + n * 16);
#pragma unroll
        for (int ai = 0; ai < 2; ++ai)
#pragma unroll
            for (int m = 0; m < 4; ++m) { const size_t off = (size_t)(row0 + ai * 128 + m * 16) * D + col0;
#pragma unroll
                for (int bj = 0; bj < 2; ++bj)
#pragma unroll
                    for (int n = 0; n < 2; ++n) { const f32x4 xv = *(const f32x4*)(x + off + bj * 128 + n * 16);
                        *(f32x4*)(z + off + bj * 128 + n * 16) = xv * DN_ALPHA + acc[ai][bj][m][n] + bv[bj][n]; } }
    }
};
struct EpiExp1 {
    static constexpr bool PERM = true;
    bf16_t* h;
    DI void operator()(const f32x4 (&acc)[2][2][4][2], const Unit& u, int wr, int wc, int fr, int fq) const {
        const int row0 = u.pm * 256 + wr * 64 + fr, col0 = u.pn * 128 + wc * 32 + 8 * fq;
#pragma unroll
        for (int ai = 0; ai < 2; ++ai)
#pragma unroll
            for (int m = 0; m < 4; ++m) { f32x4 o0, o1;
#pragma unroll
                for (int j = 0; j < 4; ++j) { o0[j] = silu_f(acc[ai][0][m][0][j]) * acc[ai][1][m][0][j]; o1[j] = silu_f(acc[ai][0][m][1][j]) * acc[ai][1][m][1][j]; }
                u32x4 w; w.x = cvt_pk_bf16(o0[0], o0[1]); w.y = cvt_pk_bf16(o0[2], o0[3]); w.z = cvt_pk_bf16(o1[0], o1[1]); w.w = cvt_pk_bf16(o1[2], o1[3]);
                *(u32x4*)(h + (size_t)(row0 + ai * 128 + m * 16) * FF + col0) = w; }
    }
};
struct EpiExp2 {
    static constexpr bool PERM = true;
    const int* row_slot; const float* row_w; bf16_t* slots;
    DI void operator()(const f32x4 (&acc)[2][2][4][2], const Unit& u, int wr, int wc, int fr, int fq) const {
        const int row0 = u.pm * 256 + wr * 64 + fr, col0 = u.pn * 256 + wc * 32 + 8 * fq;
#pragma unroll
        for (int ai = 0; ai < 2; ++ai)
#pragma unroll
            for (int m = 0; m < 4; ++m) { const int r = row0 + ai * 128 + m * 16; const int slot = row_slot[r]; const float w8 = row_w[r];
                if (slot >= 0) {
#pragma unroll
                    for (int bj = 0; bj < 2; ++bj) { const f32x4 v0 = acc[ai][bj][m][0] * w8, v1 = acc[ai][bj][m][1] * w8;
                        u32x4 w; w.x = cvt_pk_bf16(v0[0], v0[1]); w.y = cvt_pk_bf16(v0[2], v0[3]); w.z = cvt_pk_bf16(v1[0], v1[1]); w.w = cvt_pk_bf16(v1[2], v1[3]);
                        *(u32x4*)(slots + (size_t)slot * D + col0 + bj * 128) = w; } } }
    }
};
struct MoeOrder {
    const char* A; const char* Bt; int K; size_t bstride; const LAS int* ts; const int* row_tok; int G, c, gather;
    DI bool next(int i, Unit& u) const {
        const int L = i * G + c, ntile = ts[32]; if (L >= 4 * ntile) return false;
        const int tile = L >> 2, lane = threadIdx.x & 63;
        const int v = ts[lane < 32 ? lane + 1 : 32];
        const unsigned long long mk = __ballot(lane < 32 && v <= tile);
        u.pm = tile; u.pn = L & 3; u.e = __builtin_amdgcn_readfirstlane((int)__popcll(mk)); return true;
    }
    DI const char* a_ptr(const Unit& u) const { return gather ? A : A + (size_t)u.pm * 256 * K * 2; }
    DI const char* b_ptr(const Unit& u) const { return Bt + (size_t)u.e * bstride + (size_t)u.pn * 256 * K * 2; }
    DI void a_rows(const Unit& u, const int (&RA)[2], const int (&CA)[2], unsigned (&g)[2][2]) const {
#pragma unroll
        for (int h = 0; h < 2; ++h)
#pragma unroll
            for (int i = 0; i < 2; ++i) g[h][i] = (unsigned)row_tok[u.pm * 256 + h * 128 + RA[i]] * (unsigned)(K * 2) + (unsigned)CA[i];
    }
};

DI void phase_gla_pre(Frame& F, const Args& A, const bool dry) {
    LAS unsigned char* L = F.lds;
    constexpr int oQT = 0, oKT = 17408, oKE = 34816, oALR = 52224, oSEG = 56320, RS = 272;
    const int tid = F.tid, lane = F.lane, w = F.wave, kk = tid & 127, seg = tid >> 7, g = lane >> 4, fr = lane & 15;
    bf16_t* Q = wsp<bf16_t>(F, WS_Q); bf16_t* K = wsp<bf16_t>(F, WS_K); const float* ALR = wsp<float>(F, WS_ALR);
    bf16_t* PB = wsp<bf16_t>(F, WS_PBUF); float* DEC = wsp<float>(F, WS_DEC);
    for (int item = F.vcu; item < NB * 4 * 32; item += F.G) {
        const int b = item >> 7, hd = (item >> 5) & 3, n = item & 31;
        const size_t tok0 = (size_t)b * SEQ + n * 64;
        float w2[16];
#pragma unroll
        for (int r = 0; r < 16; ++r) w2[r] = A.in[I_GWA2][r * 512 + hd * 128 + kk];
        const float ba = A.in[I_GBA][hd * 128 + kk];
        __syncthreads();
#pragma unroll
        for (int c = tid; c < 1024; c += 512) { const int row = c >> 4, c16 = c & 15; const size_t go = (tok0 + row) * 512 + hd * 128 + c16 * 8;
            *(LAS u32x4*)(L + oQT + row * RS + c16 * 16) = *(const u32x4*)(Q + go); *(LAS u32x4*)(L + oKT + row * RS + c16 * 16) = *(const u32x4*)(K + go); }
        if (tid < 256) *(LAS f32x4*)(L + oALR + tid * 16) = *(const f32x4*)(ALR + tok0 * 16 + tid * 4);
        __syncthreads();
        float cs[16]; float run = 0.f;
#pragma unroll
        for (int i = 0; i < 16; ++i) { const LAS f32x4* ar = (const LAS f32x4*)(L + oALR + (16 * seg + i) * 64); const f32x4 a0 = ar[0], a1 = ar[1], a2 = ar[2], a3 = ar[3];
            float z = ba + a0.x * w2[0] + a0.y * w2[1] + a0.z * w2[2] + a0.w * w2[3] + a1.x * w2[4] + a1.y * w2[5] + a1.z * w2[6] + a1.w * w2[7]
                         + a2.x * w2[8] + a2.y * w2[9] + a2.z * w2[10] + a2.w * w2[11] + a3.x * w2[12] + a3.y * w2[13] + a3.z * w2[14] + a3.w * w2[15];
            const float la = (fminf(z, 0.f) - __logf(1.0f + fast_exp(-fabsf(z)))) * (1.0f / 16.0f);
            run += la; cs[i] = run; }
        LAS float* SEGp = (LAS float*)(L + oSEG);
        SEGp[seg * 128 + kk] = run;
        __syncthreads();
        float off = 0.f, bl = 0.f;
#pragma unroll
        for (int s = 0; s < 4; ++s) { const float v = SEGp[s * 128 + kk]; bl += v; off += (s < seg) ? v : 0.f; }
        const float eb = fast_exp(bl);
#pragma unroll
        for (int i = 0; i < 16; ++i) { const int t = 16 * seg + i; const float E = fast_exp(off + cs[i]), Ei = fast_rcp(E);
            LAS unsigned short* qp = (LAS unsigned short*)(L + oQT + t * RS) + kk; LAS unsigned short* kp = (LAS unsigned short*)(L + oKT + t * RS) + kk; LAS unsigned short* ep = (LAS unsigned short*)(L + oKE + t * RS) + kk;
            const float qv = bf2f(*qp), kv = bf2f(*kp);
            *qp = f2bf(qv * QSCALE * E); *kp = f2bf(kv * Ei); *ep = f2bf(kv * Ei * eb); }
        if (seg == 0) DEC[(size_t)item * 128 + kk] = eb;
        __syncthreads();
        const int tt = w >> 1;
#pragma unroll
        for (int j = 0; j < 2; ++j) { const int st = 2 * (w & 1) + j; f32x4 acc = {0.f, 0.f, 0.f, 0.f};
#pragma unroll
            for (int ks = 0; ks < 4; ++ks) { const bf16x8 a = *(const LAS bf16x8*)(L + oKT + (16 * st + fr) * RS + (32 * ks + 8 * g) * 2); const bf16x8 bq = *(const LAS bf16x8*)(L + oQT + (16 * tt + fr) * RS + (32 * ks + 8 * g) * 2);
                acc = MFMA16(a, bq, acc); }
            const int t = 16 * tt + fr, s0 = 16 * st + 4 * g;
            u32x2 o; o.x = cvt_pk_bf16(s0 + 0 <= t ? acc[0] : 0.f, s0 + 1 <= t ? acc[1] : 0.f); o.y = cvt_pk_bf16(s0 + 2 <= t ? acc[2] : 0.f, s0 + 3 <= t ? acc[3] : 0.f);
            if (!dry) *(u32x2*)(PB + (size_t)item * 4096 + t * 64 + s0) = o; }
#pragma unroll
        for (int c = tid; c < 1024; c += 512) { const int row = c >> 4, c16 = c & 15; const size_t go = (tok0 + row) * 512 + hd * 128 + c16 * 8;
            const u32x4 q_ = *(const LAS u32x4*)(L + oQT + row * RS + c16 * 16), k_ = *(const LAS u32x4*)(L + oKE + row * RS + c16 * 16); if (!dry) { *(u32x4*)(Q + go) = q_; *(u32x4*)(K + go) = k_; } }
    }
}

DI bf16x8 tr_pair(const LAS unsigned char* p, int rowstride4) {
    const s16x4 lo = __builtin_amdgcn_ds_read_tr16_b64_v4i16((LAS s16x4*)p);
    const s16x4 hi = __builtin_amdgcn_ds_read_tr16_b64_v4i16((LAS s16x4*)(p + rowstride4));
    return __builtin_shufflevector(lo, hi, 0, 1, 2, 3, 4, 5, 6, 7);
}
DI void phase_gla_chain(Frame& F, const Args& A) {
    LAS unsigned char* L = F.lds;
    constexpr int BUF = 53760, oQD = 0, oKE = 17408, oV = 34816, oP = 44032, oDEC = 53248, oST = 2 * BUF, RS = 272, RV = 144;
    const int tid = F.tid, lane = F.lane, w = F.wave, g = lane >> 4, fr = lane & 15, q4 = fr >> 2, p4 = fr & 3;
    const bf16_t* Q = wsp<bf16_t>(F, WS_Q); const bf16_t* K = wsp<bf16_t>(F, WS_K); const bf16_t* V = wsp<bf16_t>(F, WS_V);
    const bf16_t* PB = wsp<bf16_t>(F, WS_PBUF); const float* DEC = wsp<float>(F, WS_DEC);
    bf16_t* GB = wsp<bf16_t>(F, WS_G); float* SSQ = wsp<float>(F, WS_SSQ);
    for (int chain = F.vcu; chain < 256; chain += F.G) {
        const int b = chain >> 4, hd = (chain >> 2) & 3, vs = chain & 3;
        const int item0 = b * 128 + hd * 32; const size_t tokb = (size_t)b * SEQ;
        f32x4 S[4];
#pragma unroll
        for (int i = 0; i < 4; ++i) S[i] = (f32x4){0.f, 0.f, 0.f, 0.f};
        u32x4 pq[2], pk[2], pv, pp; float pd = 0.f;
        const int r16 = tid >> 4, c16 = tid & 15, r8 = tid >> 3, c8 = tid & 7;
#define GC_LOAD(n_) do { const size_t t0_ = tokb + (size_t)(n_) * 64; const int it_ = item0 + (n_); \
            pq[0] = *(const u32x4*)(Q + (t0_ + r16) * 512 + hd * 128 + c16 * 8); pq[1] = *(const u32x4*)(Q + (t0_ + r16 + 32) * 512 + hd * 128 + c16 * 8); \
            pk[0] = *(const u32x4*)(K + (t0_ + r16) * 512 + hd * 128 + c16 * 8); pk[1] = *(const u32x4*)(K + (t0_ + r16 + 32) * 512 + hd * 128 + c16 * 8); \
            pv = *(const u32x4*)(V + (t0_ + r8) * 1024 + hd * 256 + vs * 64 + c8 * 8); pp = *(const u32x4*)(PB + (size_t)it_ * 4096 + r8 * 64 + c8 * 8); \
            if (tid < 128) pd = DEC[(size_t)it_ * 128 + tid]; } while (0)
#define GC_WRITE(bo_) do { *(LAS u32x4*)(L + (bo_) + oQD + r16 * RS + c16 * 16) = pq[0]; *(LAS u32x4*)(L + (bo_) + oQD + (r16 + 32) * RS + c16 * 16) = pq[1]; \
            *(LAS u32x4*)(L + (bo_) + oKE + r16 * RS + c16 * 16) = pk[0]; *(LAS u32x4*)(L + (bo_) + oKE + (r16 + 32) * RS + c16 * 16) = pk[1]; \
            *(LAS u32x4*)(L + (bo_) + oV + r8 * RV + c8 * 16) = pv; *(LAS u32x4*)(L + (bo_) + oP + r8 * RV + c8 * 16) = pp; \
            if (tid < 128) *(LAS float*)(L + (bo_) + oDEC + tid * 4) = pd; } while (0)
        __syncthreads();
        for (int i = tid; i < 64 * RS / 16; i += 512) *(LAS u32x4*)(L + oST + i * 16) = (u32x4){0u, 0u, 0u, 0u};
        GC_LOAD(0); GC_WRITE(0);
        __syncthreads();
        const int tt = w >> 1, trow = 16 * tt + fr;
        f32x4 gnv[2]; u32x2 gq[2], gqn[2];
#pragma unroll
        for (int j = 0; j < 2; ++j) { gnv[j] = *(const f32x4*)(A.in[I_GNORM] + hd * 256 + vs * 64 + 16 * (2 * (w & 1) + j) + 4 * g);
            gqn[j] = *(const u32x2*)(GB + (tokb + trow) * 1024 + hd * 256 + vs * 64 + 16 * (2 * (w & 1) + j) + 4 * g); }
        for (int n = 0; n < 32; ++n) {
            const int cur = (n & 1) * BUF;
            if (n + 1 < 32) GC_LOAD(n + 1);
#pragma unroll
            for (int j = 0; j < 2; ++j) { gq[j] = gqn[j]; if (n + 1 < 32) gqn[j] = *(const u32x2*)(GB + (tokb + (size_t)(n + 1) * 64 + trow) * 1024 + hd * 256 + vs * 64 + 16 * (2 * (w & 1) + j) + 4 * g); }
            bf16x8 pf[2], qf[4];
#pragma unroll
            for (int ks = 0; ks < 2; ++ks) pf[ks] = *(const LAS bf16x8*)(L + cur + oP + trow * RV + (32 * ks + 8 * g) * 2);
#pragma unroll
            for (int ks = 0; ks < 4; ++ks) qf[ks] = *(const LAS bf16x8*)(L + cur + oQD + trow * RS + (32 * ks + 8 * g) * 2);
            float ss = 0.f;
#pragma unroll
            for (int j = 0; j < 2; ++j) { const int vt = 2 * (w & 1) + j; f32x4 o = {0.f, 0.f, 0.f, 0.f};
#pragma unroll
                for (int ks = 0; ks < 2; ++ks) { const bf16x8 vf = tr_pair(L + cur + oV + (32 * ks + 8 * g + q4) * RV + (16 * vt + 4 * p4) * 2, 4 * RV); o = MFMA16(vf, pf[ks], o); }
#pragma unroll
                for (int ks = 0; ks < 4; ++ks) { const bf16x8 sf = *(const LAS bf16x8*)(L + oST + (16 * vt + fr) * RS + (32 * ks + 8 * g) * 2); o = MFMA16(sf, qf[ks], o); }
                ss += o[0] * o[0] + o[1] * o[1] + o[2] * o[2] + o[3] * o[3];
                const float g0 = bf_lo(gq[j].x), g1 = bf_hi(gq[j].x), g2 = bf_lo(gq[j].y), g3 = bf_hi(gq[j].y);
                u32x2 ob; ob.x = cvt_pk_bf16(o[0] * gnv[j][0] * silu_f(g0), o[1] * gnv[j][1] * silu_f(g1)); ob.y = cvt_pk_bf16(o[2] * gnv[j][2] * silu_f(g2), o[3] * gnv[j][3] * silu_f(g3));
                *(u32x2*)(GB + (tokb + (size_t)n * 64 + trow) * 1024 + hd * 256 + vs * 64 + 16 * vt + 4 * g) = ob; }
            ss += __shfl_xor(ss, 16); ss += __shfl_xor(ss, 32);
            if (g == 0) SSQ[((tokb + (size_t)n * 64 + trow) * 4 + hd) * 8 + vs * 2 + (w & 1)] = ss;
            const f32x4 d4 = *(const LAS f32x4*)(L + cur + oDEC + (16 * w + 4 * g) * 4);
#pragma unroll
            for (int vt = 0; vt < 4; ++vt) S[vt] = S[vt] * d4;
#pragma unroll
            for (int ks = 0; ks < 2; ++ks) { const bf16x8 kf = tr_pair(L + cur + oKE + (32 * ks + 8 * g + q4) * RS + (16 * w + 4 * p4) * 2, 4 * RS);
#pragma unroll
                for (int vt = 0; vt < 4; ++vt) { const bf16x8 vf = tr_pair(L + cur + oV + (32 * ks + 8 * g + q4) * RV + (16 * vt + 4 * p4) * 2, 4 * RV); S[vt] = MFMA16(kf, vf, S[vt]); } }
            __syncthreads();
#pragma unroll
            for (int vt = 0; vt < 4; ++vt) { u32x2 sb; sb.x = cvt_pk_bf16(S[vt][0], S[vt][1]); sb.y = cvt_pk_bf16(S[vt][2], S[vt][3]);
                *(LAS u32x2*)(L + oST + (16 * vt + fr) * RS + (16 * w + 4 * g) * 2) = sb; }
            if (n + 1 < 32) GC_WRITE(BUF - cur);
            __syncthreads();
        }
#undef GC_LOAD
#undef GC_WRITE
    }
}

DI void phase_rnn_chain(Frame& F, const Args& A, const bool dry) {
    LAS unsigned char* L = F.lds;
    constexpr int oU = 0, RU = 272, oA = 34816, oB = 68608, RAB = 528, oH = 34816, RH = 272, oSA = 102400, oSB = 104448, oHC = 106496, oCW = 107008, oGW = 109568;
    const int tid = F.tid, lane = F.lane, w = F.wave, g = lane >> 4, fr = lane & 15, wt = w >> 1, wn = w & 1;
    const bf16_t* RX = wsp<bf16_t>(F, WS_RX); bf16_t* RY = wsp<bf16_t>(F, WS_RY); const bf16_t* RGT = wsp<bf16_t>(F, WS_RGT);
    for (int chain = F.vcu; chain < 256; chain += F.G) {
        const int b = chain >> 4, blk = (chain >> 1) & 7, half = chain & 1, C0 = blk * 128, OC0 = C0 + half * 64;
        __syncthreads();
        for (int i = tid; i < 640; i += 512) { const int k = i >> 7, c = i & 127; ((LAS float*)(L + oCW))[i] = (k < 4) ? A.in[I_CONVW][k * 1024 + C0 + c] : A.in[I_CONVB][C0 + c]; }
        if (tid < 128) ((LAS float*)(L + oHC))[tid] = 0.f;
        for (int i = tid; i < 2048; i += 512) { const int row = i >> 4, c16 = i & 15, G2 = row >> 6, ocl = row & 63;
            *(LAS u32x4*)(L + oGW + row * RU + c16 * 16) = *(const u32x4*)(RGT + ((size_t)(blk * 2 + G2) * 128 + half * 64 + ocl) * 128 + c16 * 8); }
        float ba[2], bx[2], c8[2];
#pragma unroll
        for (int nt = 0; nt < 2; ++nt) { const int oc = half * 64 + 32 * wn + 16 * nt + fr;
            ba[nt] = A.in[I_RGBA][C0 + oc]; bx[nt] = A.in[I_RGBX][C0 + oc]; c8[nt] = 8.0f * log1pf(expf(-A.in[I_LAM][C0 + oc])); }
        const int tl = tid >> 4, cg = tid & 15;
        u32x4 xr[7], yr[2];
#define RN_LOADX(t0_) do { _Pragma("unroll") for (int i_ = 0; i_ < 7; ++i_) { const int si_ = (t0_) + 4 * tl - 3 + i_; \
            xr[i_] = (si_ >= 0) ? *(const u32x4*)(RX + ((size_t)b * SEQ + si_) * 1024 + C0 + 8 * cg) : (u32x4){0u, 0u, 0u, 0u}; } } while (0)
        RN_LOADX(0);
        __syncthreads();
        for (int j = 0; j < SEQ / 128; ++j) {
            const int t0 = j * 128;
            { f32x4 cw[5][2];
#pragma unroll
              for (int k = 0; k < 5; ++k) { cw[k][0] = *(const LAS f32x4*)(L + oCW + (k * 128 + 8 * cg) * 4); cw[k][1] = *(const LAS f32x4*)(L + oCW + (k * 128 + 8 * cg + 4) * 4); }
              float xf[7][8];
#pragma unroll
              for (int i = 0; i < 7; ++i) unpack8(xr[i], xf[i]);
#pragma unroll
              for (int i = 0; i < 4; ++i) { float u8[8];
#pragma unroll
                  for (int c = 0; c < 8; ++c) { float u = cw[4][c >> 2][c & 3];
#pragma unroll
                      for (int k = 0; k < 4; ++k) u += cw[k][c >> 2][c & 3] * xf[i + k][c];
                      u8[c] = u; }
                  u32x4 uw; uw.x = cvt_pk_bf16(u8[0], u8[1]); uw.y = cvt_pk_bf16(u8[2], u8[3]); uw.z = cvt_pk_bf16(u8[4], u8[5]); uw.w = cvt_pk_bf16(u8[6], u8[7]);
                  *(LAS u32x4*)(L + oU + (4 * tl + i) * RU + cg * 16) = uw; } }
            __syncthreads();
            if (j + 1 < SEQ / 128) RN_LOADX(t0 + 128);
#pragma unroll
            for (int i = 0; i < 2; ++i) { const int idx = tid + 512 * i, tok = idx >> 3, cgp = idx & 7; yr[i] = *(const u32x4*)(RY + ((size_t)b * SEQ + t0 + tok) * 1024 + OC0 + 8 * cgp); }
            f32x4 aa[2][2], ax[2][2];
#pragma unroll
            for (int mt = 0; mt < 2; ++mt)
#pragma unroll
                for (int nt = 0; nt < 2; ++nt) { aa[mt][nt] = (f32x4){0.f, 0.f, 0.f, 0.f}; ax[mt][nt] = (f32x4){0.f, 0.f, 0.f, 0.f}; }
#pragma unroll
            for (int ks = 0; ks < 4; ++ks)
#pragma unroll
                for (int mt = 0; mt < 2; ++mt) { const bf16x8 af = *(const LAS bf16x8*)(L + oU + (32 * wt + 16 * mt + fr) * RU + (32 * ks + 8 * g) * 2);
#pragma unroll
                    for (int nt = 0; nt < 2; ++nt) { const bf16x8 b0 = *(const LAS bf16x8*)(L + oGW + (32 * wn + 16 * nt + fr) * RU + (32 * ks + 8 * g) * 2), b1 = *(const LAS bf16x8*)(L + oGW + (64 + 32 * wn + 16 * nt + fr) * RU + (32 * ks + 8 * g) * 2);
                        aa[mt][nt] = MFMA16(af, b0, aa[mt][nt]); ax[mt][nt] = MFMA16(af, b1, ax[mt][nt]); } }
#pragma unroll
            for (int mt = 0; mt < 2; ++mt)
#pragma unroll
                for (int nt = 0; nt < 2; ++nt) { const int o = 32 * wn + 16 * nt + fr, tk = 32 * wt + 16 * mt + 4 * g; f32x4 av, bv;
#pragma unroll
                    for (int r = 0; r < 4; ++r) { const float uval = bf2f(*((const LAS unsigned short*)(L + oU + (tk + r) * RU) + half * 64 + o));
                        const float rg = sigmoid_f(aa[mt][nt][r] + ba[nt]), ig = sigmoid_f(ax[mt][nt][r] + bx[nt]);
                        const float a = fast_exp(-c8[nt] * rg); const float mult = __builtin_amdgcn_sqrtf(fmaxf(1.0f - a * a, 0.f));
                        av[r] = a; bv[r] = mult * ig * uval; }
                    *(LAS f32x4*)(L + oA + o * RAB + tk * 4) = av; *(LAS f32x4*)(L + oB + o * RAB + tk * 4) = bv; }
            __syncthreads();
            { const int ch = tid >> 3, sg = tid & 7; float a16[16], h16[16];
#pragma unroll
              for (int q = 0; q < 4; ++q) { const f32x4 av = *(const LAS f32x4*)(L + oA + ch * RAB + (16 * sg + 4 * q) * 4), bv = *(const LAS f32x4*)(L + oB + ch * RAB + (16 * sg + 4 * q) * 4);
#pragma unroll
                  for (int r = 0; r < 4; ++r) { a16[4 * q + r] = av[r]; h16[4 * q + r] = bv[r]; } }
              float ac = 1.f, hl = 0.f;
#pragma unroll
              for (int i = 0; i < 16; ++i) { hl = a16[i] * hl + h16[i]; ac *= a16[i]; h16[i] = hl; a16[i] = ac; }
              ((LAS float*)(L + oSA))[ch * 8 + sg] = ac; ((LAS float*)(L + oSB))[ch * 8 + sg] = hl;
              __syncthreads();
              float carry = ((const LAS float*)(L + oHC))[(j & 1) * 64 + ch];
#pragma unroll
              for (int s = 0; s < 7; ++s) { const float sa = ((const LAS float*)(L + oSA))[ch * 8 + s], sb = ((const LAS float*)(L + oSB))[ch * 8 + s]; carry = (s < sg) ? sa * carry + sb : carry; }
#pragma unroll
              for (int i = 0; i < 16; ++i) { const float h = h16[i] + a16[i] * carry; h16[i] = h; *(LAS float*)(L + oH + (16 * sg + i) * RH + ch * 4) = h; }
              if (sg == 7) ((LAS float*)(L + oHC))[((j + 1) & 1) * 64 + ch] = h16[15]; }
            __syncthreads();
#pragma unroll
            for (int i = 0; i < 2; ++i) { const int idx = tid + 512 * i, tok = idx >> 3, cgp = idx & 7; float yf[8]; unpack8(yr[i], yf);
                const f32x4 h0 = *(const LAS f32x4*)(L + oH + tok * RH + cgp * 32), h1 = *(const LAS f32x4*)(L + oH + tok * RH + cgp * 32 + 16);
                float r[8];
#pragma unroll
                for (int c = 0; c < 4; ++c) { r[c] = h0[c] * gelu_tanh_f(yf[c]); r[4 + c] = h1[c] * gelu_tanh_f(yf[4 + c]); }
                u32x4 wv; wv.x = cvt_pk_bf16(r[0], r[1]); wv.y = cvt_pk_bf16(r[2], r[3]); wv.z = cvt_pk_bf16(r[4], r[5]); wv.w = cvt_pk_bf16(r[6], r[7]);
                if (!dry) *(u32x4*)(RY + ((size_t)b * SEQ + t0 + tok) * 1024 + OC0 + 8 * cgp) = wv; }
        }
#undef RN_LOADX
    }
}

DI void phase_ln1_router(Frame& F, const Args& A, const float* zsrc, float zscale, const bool dry) {
    LAS unsigned char* L = F.lds;
    LAS float* WRE = (LAS float*)L;
    LAS float* WRG = (LAS float*)(L + AUX_OFF);
    LAS int* HIST = (LAS int*)(L + LDSCTL_OFF + 64);
    const int tid = F.tid, lane = F.lane, w = F.wave;
    bf16_t* X1B = wsp<bf16_t>(F, WS_X1B); int* TOKE = wsp<int>(F, WS_TOKE); float* TOKW = wsp<float>(F, WS_TOKW);
    __syncthreads();
    for (int i = tid; i < 32 * 1024; i += 512) { const int k = i >> 5, e = i & 31; WRE[e * 1024 + k] = A.in[I_RWE][i]; }
    for (int i = tid; i < 4 * 1024; i += 512) { const int k = i >> 2, e = i & 3; WRG[e * 1024 + k] = A.in[I_RWG][i]; }
    if (tid < 32) HIST[tid] = 0;
    __syncthreads();
    f32x4 g1[4], b1[4];
#pragma unroll
    for (int j = 0; j < 4; ++j) { g1[j] = *((const f32x4*)A.in[I_LN1G] + lane + 64 * j); b1[j] = *((const f32x4*)A.in[I_LN1B] + lane + 64 * j); }
    const int TPW = NTOK / F.G;
    for (int it = 0; it < TPW / 16; ++it) {
        const int m = F.vcu * TPW + it * 16 + w * 2;
        f32x4 xv[2][4];
#pragma unroll
        for (int r = 0; r < 2; ++r) { float s = 0.f;
#pragma unroll
            for (int j = 0; j < 4; ++j) { xv[r][j] = *((const f32x4*)(zsrc + (size_t)(m + r) * D) + lane + 64 * j) * zscale; s += (xv[r][j].x + xv[r][j].y) + (xv[r][j].z + xv[r][j].w); }
            const float mean = wave_sum(s) * (1.f / D); float s2 = 0.f;
#pragma unroll
            for (int j = 0; j < 4; ++j) { xv[r][j] = xv[r][j] - mean; s2 += (xv[r][j].x * xv[r][j].x + xv[r][j].y * xv[r][j].y) + (xv[r][j].z * xv[r][j].z + xv[r][j].w * xv[r][j].w); }
            const float rstd = __builtin_amdgcn_rsqf(wave_sum(s2) * (1.f / D) + LN_EPS);
#pragma unroll
            for (int j = 0; j < 4; ++j) { xv[r][j] = xv[r][j] * rstd * g1[j] + b1[j];
                u32x2 wv; wv.x = cvt_pk_bf16(xv[r][j].x, xv[r][j].y); wv.y = cvt_pk_bf16(xv[r][j].z, xv[r][j].w);
                if (!dry) *(u32x2*)(X1B + (size_t)(m + r) * D + 4 * lane + 256 * j) = wv; } }
        float gl[2][4];
#pragma unroll
        for (int e = 0; e < 4; ++e) { float s0 = 0.f, s1 = 0.f;
#pragma unroll
            for (int j = 0; j < 4; ++j) { const f32x4 wv = *(const LAS f32x4*)(WRG + e * 1024 + 256 * j + 4 * lane);
                s0 += xv[0][j].x * wv.x + xv[0][j].y * wv.y + xv[0][j].z * wv.z + xv[0][j].w * wv.w; s1 += xv[1][j].x * wv.x + xv[1][j].y * wv.y + xv[1][j].z * wv.z + xv[1][j].w * wv.w; }
            gl[0][e] = wave_sum(s0) + A.in[I_RBG][e]; gl[1][e] = wave_sum(s1) + A.in[I_RBG][e]; }
#pragma unroll
        for (int r = 0; r < 2; ++r) {
            int grp = 0; float gmax = gl[r][0];
#pragma unroll
            for (int e = 1; e < 4; ++e) if (gl[r][e] > gmax) { gmax = gl[r][e]; grp = e; }
            grp = __builtin_amdgcn_readfirstlane(grp);
            float gs = 0.f;
#pragma unroll
            for (int e = 0; e < 4; ++e) gs += __expf(gl[r][e] - gmax);
            const float pg = 1.0f / gs;
            float el[8];
#pragma unroll
            for (int e = 0; e < 8; ++e) { float s = 0.f;
#pragma unroll
                for (int j = 0; j < 4; ++j) { const f32x4 wv = *(const LAS f32x4*)(WRE + (grp * 8 + e) * 1024 + 256 * j + 4 * lane);
                    s += xv[r][j].x * wv.x + xv[r][j].y * wv.y + xv[r][j].z * wv.z + xv[r][j].w * wv.w; }
                el[e] = wave_sum(s) + A.in[I_RBE][grp * 8 + e]; }
            int i0 = 0; float m0 = el[0];
#pragma unroll
            for (int e = 1; e < 8; ++e) if (el[e] > m0) { m0 = el[e]; i0 = e; }
            int i1 = -1; float m1 = -3.0e38f;
#pragma unroll
            for (int e = 0; e < 8; ++e) if (e != i0 && el[e] > m1) { m1 = el[e]; i1 = e; }
            const float p1 = __expf(m1 - m0), inv = 1.0f / (1.0f + p1);
            if (lane == 0 && !dry) { const int e0 = grp * 8 + i0, e1 = grp * 8 + i1;
                TOKE[(size_t)(m + r) * 2] = e0; TOKE[(size_t)(m + r) * 2 + 1] = e1; TOKW[(size_t)(m + r) * 2] = pg * inv; TOKW[(size_t)(m + r) * 2 + 1] = pg * p1 * inv;
                atomicAdd((int*)(HIST + e0), 1); atomicAdd((int*)(HIST + e1), 1); }
        }
    }
    __syncthreads();
    if (tid < 32 && !dry) ((int*)F.ctl)[CW_WGCNT + F.vcu * 32 + tid] = HIST[tid];
}

DI void phase_dispatch(Frame& F, const Args& A) {
    LAS int* TOT = (LAS int*)(F.lds + LDSCTL_OFF + 256); LAS int* PB = TOT + 32; LAS int* POFF = TOT + 64; LAS int* CUR = TOT + 96;
    const int tid = F.tid; const int* WGC = (const int*)F.ctl + CW_WGCNT; const int* TOKE = wsp<int>(F, WS_TOKE); const float* TOKW = wsp<float>(F, WS_TOKW);
    int* row_tok = wsp<int>(F, WS_ROWS); float* row_w = (float*)(row_tok + MAXROWS); int* row_slot = row_tok + 2 * MAXROWS;
    __syncthreads();
    if (tid < 32) { int tot = 0, before = 0; for (int g = 0; g < F.G; ++g) { const int c = WGC[g * 32 + tid]; tot += c; before += (g < F.vcu) ? c : 0; } TOT[tid] = tot; PB[tid] = before; CUR[tid] = 0; }
    __syncthreads();
    if (tid == 0) { int po = 0; for (int e = 0; e < 32; ++e) { POFF[e] = po; if (F.vcu == 0) ((int*)F.ctl)[CW_TS + e] = po >> 8; po += (TOT[e] + 255) & ~255; } if (F.vcu == 0) ((int*)F.ctl)[CW_TS + 32] = po >> 8; }
    __syncthreads();
    const int TPW = NTOK / F.G;
    for (int a = tid; a < 2 * TPW; a += 512) { const int t = F.vcu * TPW + (a >> 1), k = a & 1; const int e = TOKE[(size_t)t * 2 + k];
        const int pos = POFF[e] + PB[e] + atomicAdd((int*)(CUR + e), 1);
        row_tok[pos] = t; row_w[pos] = TOKW[(size_t)t * 2 + k]; row_slot[pos] = 2 * t + k; }
    for (int e = F.vcu; e < 32; e += F.G) { const int lo = POFF[e] + TOT[e], hi = POFF[e] + ((TOT[e] + 255) & ~255);
        for (int r = lo + tid; r < hi; r += 512) { row_tok[r] = 0; row_w[r] = 0.f; row_slot[r] = -1; } }
}

DI void phase_final(Frame& F, const Args& A, int use_moe, const bool dry) {
    const int lane = F.lane; const int gw = F.vcu * NWAVES + F.wave, NGW = F.G * NWAVES;
    float* X1 = F.out; const bf16_t* SL = wsp<bf16_t>(F, WS_SLOTS); const bf16_t* X1B = wsp<bf16_t>(F, WS_X1B);
    f32x4 g2[4], b2[4];
#pragma unroll
    for (int j = 0; j < 4; ++j) { g2[j] = *((const f32x4*)A.in[I_LN2G] + lane + 64 * j); b2[j] = *((const f32x4*)A.in[I_LN2B] + lane + 64 * j); }
    for (int m = gw; m < NTOK; m += NGW) {
        f32x4 v[4]; float s = 0.f;
#pragma unroll
        for (int j = 0; j < 4; ++j) { { const u32x2 xw = *(const u32x2*)(X1B + (size_t)m * D + 4 * lane + 256 * j); v[j] = (f32x4){bf_lo(xw.x), bf_hi(xw.x), bf_lo(xw.y), bf_hi(xw.y)} * DN_ALPHA; }
            if (use_moe) { const u32x2 a = *(const u32x2*)(SL + (size_t)(2 * m) * D + 4 * lane + 256 * j), c = *(const u32x2*)(SL + (size_t)(2 * m + 1) * D + 4 * lane + 256 * j);
                v[j].x += bf_lo(a.x) + bf_lo(c.x); v[j].y += bf_hi(a.x) + bf_hi(c.x); v[j].z += bf_lo(a.y) + bf_lo(c.y); v[j].w += bf_hi(a.y) + bf_hi(c.y); }
            s += (v[j].x + v[j].y) + (v[j].z + v[j].w); }
        const float mean = wave_sum(s) * (1.f / D); float s2 = 0.f;
#pragma unroll
        for (int j = 0; j < 4; ++j) { v[j] = v[j] - mean; s2 += (v[j].x * v[j].x + v[j].y * v[j].y) + (v[j].z * v[j].z + v[j].w * v[j].w); }
        const float rstd = __builtin_amdgcn_rsqf(wave_sum(s2) * (1.f / D) + LN_EPS);
#pragma unroll
        for (int j = 0; j < 4; ++j) { const f32x4 o_ = v[j] * rstd * g2[j] + b2[j]; if (!dry) *((f32x4*)(X1 + (size_t)m * D) + lane + 64 * j) = o_; }
    }
}

constexpr int N_PHASES = 11;
__global__ void __launch_bounds__(NWAVES * 64, 2) fwd(Args args) {
    extern __shared__ __attribute__((aligned(16))) unsigned char lds[];
    Frame F;
    F.lds = (LAS unsigned char*)lds;
    F.tid = threadIdx.x; F.lane = F.tid & 63; F.wave = __builtin_amdgcn_readfirstlane(F.tid >> 6);
    F.G = gridDim.x; { const int bx = blockIdx.x; F.vcu = (F.G % 8 == 0) ? (bx % 8) * (F.G / 8) + bx / 8 : bx; }
    F.ws = args.ws; F.ctl = (unsigned*)(args.ws + WS_CTL); F.out = args.out;
    for (int u = F.tid; u < (LDS_BYTES - LDSCTL_OFF) / 4; u += NWAVES * 64) ((LAS unsigned*)(F.lds + LDSCTL_OFF))[u] = 0u;
    __syncthreads();
    const int lo = args.ph_lo, hi = args.ph_hi;
    XcdBarrier bar; bar.bar = F.ctl + CW_BAR; bar.x = 0; bar.st = nullptr;
    if (hi - lo > 1) bar = xcd_barrier_post(F.ctl + CW_BAR, (volatile LAS unsigned*)(F.lds + LDSCTL_OFF));
#define IN(k) (lo <= (k) && (k) < hi)
#define SEAM(k) do { if (IN(k) && IN((k) + 1)) xcd_barrier(bar); } while (0)
    LAS unsigned char* ring = F.lds;
    constexpr int ST = MK_STAGE;
#define DUP(k) ((MK_DUP >> (k)) & 1)
    if (IN(0)) { if (DUP(0)) p0_prologue(F, args); p0_prologue(F, args); } SEAM(0);
    if (IN(1)) {
#pragma unroll
        for (int rep = 0; rep < 1 + DUP(1); ++rep) {
        pg8::StaticOrder S; S.init(wsp<bf16_t>(F, WS_XB), wsp<bf16_t>(F, WS_WIN), NTOK, NPROJ, D, F.G, (int)blockIdx.x);
        EpiProj E{wsp<bf16_t>(F, WS_RX), wsp<bf16_t>(F, WS_RY), wsp<bf16_t>(F, WS_Q), wsp<bf16_t>(F, WS_K), wsp<bf16_t>(F, WS_V), wsp<bf16_t>(F, WS_G), (bf16_t*)F.out, (bf16_t*)F.out + (size_t)NTOK * D, args.in[I_BIN]};
        pg8::gemm_phase<EpiProj, pg8::StaticOrder, pg8::NoHook, false, true, true>(ring, D, S, E, pg8::NoHook{}); } } SEAM(1);
    if (IN(2)) { if (DUP(2)) { phase_gla_pre(F, args, args.dup != 0); phase_rnn_chain(F, args, args.dup != 0); } phase_gla_pre(F, args, false); phase_rnn_chain(F, args, false); } SEAM(2);
    if (IN(3)) { phase_gla_chain(F, args); } SEAM(3);
    if (IN(4)) {
        LAS float* rstab = (LAS float*)(F.lds + AUX_OFF);
        { pg8::StaticOrder S0; S0.init(wsp<bf16_t>(F, WS_RY), wsp<bf16_t>(F, WS_WR), NTOK, D, D, F.G, (int)blockIdx.x);
          pg8::Unit u; const int ui = F.tid >> 8, r = F.tid & 255;
          __syncthreads();
          if (S0.next(ui, u)) { const float* sq = wsp<float>(F, WS_SSQ) + ((size_t)(u.pm * 256 + r) * 4) * 8; f32x4 o;
#pragma unroll
              for (int h = 0; h < 4; ++h) { const f32x4 s0 = *(const f32x4*)(sq + h * 8), s1 = *(const f32x4*)(sq + h * 8 + 4); o[h] = __builtin_amdgcn_rsqf(((s0.x + s0.y) + (s0.z + s0.w) + (s1.x + s1.y) + (s1.z + s1.w)) * (1.0f / 256.0f) + RMS_EPS); }
              *(LAS f32x4*)(rstab + (ui * 256 + r) * 4) = o; }
          __syncthreads(); }
        { pg8::StaticOrder S; S.init(wsp<bf16_t>(F, WS_RY), wsp<bf16_t>(F, WS_WR), NTOK, D, D, F.G, (int)blockIdx.x);
          EpiMergeA E{(const bf16_t*)F.out, wsp<bf16_t>(F, WS_TMP)};
          pg8::gemm_phase<EpiMergeA, pg8::StaticOrder, pg8::NoHook, false, true, true>(ring, D, S, E, pg8::NoHook{}); }
        { pg8::StaticOrder S; S.init(wsp<bf16_t>(F, WS_G), wsp<bf16_t>(F, WS_WG), NTOK, D, D, F.G, (int)blockIdx.x);
          RowHook H{rstab};
          EpiMergeB E{(const bf16_t*)F.out + (size_t)NTOK * D, wsp<bf16_t>(F, WS_TMP), wsp<bf16_t>(F, WS_MERGED), rstab};
          pg8::gemm_phase<EpiMergeB, pg8::StaticOrder, RowHook, false, true, true>(ring, D, S, E, H); } } SEAM(4);
    if (IN(5)) {
#pragma unroll
        for (int rep = 0; rep < 1 + DUP(5); ++rep) {
        pg8::StaticOrder S; S.init(wsp<bf16_t>(F, WS_MERGED), wsp<bf16_t>(F, WS_WO), NTOK, D, D, F.G, (int)blockIdx.x);
        EpiWo E{args.in[I_X], args.in[I_BO], F.out};
        pg8::gemm_phase<EpiWo, pg8::StaticOrder, pg8::NoHook, false, true, true>(ring, D, S, E, pg8::NoHook{}); } } SEAM(5);
    if (IN(6)) { if (DUP(6)) phase_ln1_router(F, args, F.out, 1.0f, args.dup != 0); phase_ln1_router(F, args, F.out, 1.0f, false); } SEAM(6);
    if (IN(7)) { if (DUP(7)) phase_dispatch(F, args); phase_dispatch(F, args); } SEAM(7);
    if (IN(8)) {
#pragma unroll
        for (int rep = 0; rep < 1 + DUP(8); ++rep) {
        LAS int* ts = (LAS int*)(F.lds + LDSCTL_OFF + 768);
        __syncthreads(); if (F.tid < 33) ts[F.tid] = ((const int*)F.ctl)[CW_TS + F.tid]; __syncthreads();
        MoeOrder S{(const char*)wsp<bf16_t>(F, WS_X1B), (const char*)wsp<bf16_t>(F, WS_E13), D, (size_t)1024 * 1024 * 2, ts, wsp<int>(F, WS_ROWS), F.G, (int)blockIdx.x, 1};
        EpiExp1 E{wsp<bf16_t>(F, WS_H)};
        pg8::gemm_phase<EpiExp1, MoeOrder, pg8::NoHook, true, true, true>(ring, D, S, E, pg8::NoHook{}); } } SEAM(8);
    if (IN(9)) {
#pragma unroll
        for (int rep = 0; rep < 1 + DUP(9); ++rep) {
        LAS int* ts = (LAS int*)(F.lds + LDSCTL_OFF + 768);
        __syncthreads(); if (F.tid < 33) ts[F.tid] = ((const int*)F.ctl)[CW_TS + F.tid]; __syncthreads();
        MoeOrder S{(const char*)wsp<bf16_t>(F, WS_H), (const char*)wsp<bf16_t>(F, WS_E2), FF, (size_t)1024 * 512 * 2, ts, wsp<int>(F, WS_ROWS), F.G, (int)blockIdx.x, 0};
        EpiExp2 E{wsp<int>(F, WS_ROWS) + 2 * MAXROWS, (const float*)(wsp<int>(F, WS_ROWS) + MAXROWS), wsp<bf16_t>(F, WS_SLOTS)};
        pg8::gemm_phase<EpiExp2, MoeOrder, pg8::NoHook, false, true, true>(ring, FF, S, E, pg8::NoHook{}); } } SEAM(9);
    if (IN(10)) { if (DUP(10)) phase_final(F, args, 1, args.dup != 0); phase_final(F, args, 1, false); }
#undef IN
#undef SEAM
}

extern "C" void kernel_launch(void* const* d_in, const int* in_sizes, int n_in, void* d_out, int out_size, void* d_ws, size_t ws_size, hipStream_t stream) {
    static int grid = 0;
    if (grid == 0) {
        if (n_in != 28 || in_sizes[0] != NTOK * D || out_size != NTOK * D || ws_size < WS_END) { fprintf(stderr, "kernel_launch: unexpected shapes (n_in %d, in0 %d, out %d, ws %zu); nothing launched\n", n_in, n_in > 0 ? in_sizes[0] : -1, out_size, ws_size); grid = -1; return; }
        int dev = 0, cus = 0, per_cu = 0;
        if (hipGetDevice(&dev) != hipSuccess || hipDeviceGetAttribute(&cus, hipDeviceAttributeMultiprocessorCount, dev) != hipSuccess) { grid = -1; return; }
        if (hipFuncSetAttribute((const void*)fwd, hipFuncAttributeMaxDynamicSharedMemorySize, LDS_BYTES) != hipSuccess) { fprintf(stderr, "kernel_launch: hipFuncSetAttribute failed\n"); grid = -1; return; }
        if (hipOccupancyMaxActiveBlocksPerMultiprocessor(&per_cu, (const void*)fwd, NWAVES * 64, LDS_BYTES) != hipSuccess || per_cu < 1) { fprintf(stderr, "kernel_launch: occupancy query reports %d workgroups per CU\n", per_cu); }
        (void)hipGetLastError();
        grid = cus;
        if (grid != 256) { fprintf(stderr, "kernel_launch: built for 256 CUs, found %d; nothing launched\n", cus); grid = -1; return; }
    }
    if (grid < 0) return;
    if (hipMemsetAsync((char*)d_ws + WS_CTL, 0, CTL_ZERO_BYTES, stream) != hipSuccess) return;
    Args a{};
    for (int i = 0; i < 28; ++i) a.in[i] = (const float*)d_in[i];
    a.out = (float*)d_out; a.ws = (unsigned char*)d_ws; a.dup = MK_DUP; a.pad = 0;
#if MK_ONE_LAUNCH
    a.ph_lo = 0; a.ph_hi = N_PHASES;
    hipLaunchKernelGGL(fwd, dim3(grid), dim3(NWAVES * 64), LDS_BYTES, stream, a);
#else
    for (int p = 0; p < N_PHASES; ++p) { a.ph_lo = p; a.ph_hi = p + 1; hipLaunchKernelGGL(fwd, dim3(grid), dim3(NWAVES * 64), LDS_BYTES, stream, a); }
#endif
}
```

```cpp
#include <hip/hip_runtime.h>
#include <cstdio>
#include <cstdint>

#ifndef MK_ONE_LAUNCH
#define MK_ONE_LAUNCH 1
#endif
#ifndef MK_DIAG
#define MK_DIAG -1
#endif
#ifndef MK_DUP
#define MK_DUP 0
#endif
#ifndef MK_STAGE
#define MK_STAGE 9
#endif

#define GAS __attribute__((address_space(1)))
#define LAS __attribute__((address_space(3)))
typedef unsigned short bf16_t;
typedef short bf16x8 __attribute__((ext_vector_type(8)));
typedef short s16x4 __attribute__((ext_vector_type(4)));
typedef float f32x4 __attribute__((ext_vector_type(4)));
typedef float f32x2 __attribute__((ext_vector_type(2)));
typedef unsigned u32x4 __attribute__((ext_vector_type(4)));
typedef unsigned u32x2 __attribute__((ext_vector_type(2)));
#define DI __device__ __forceinline__

typedef __bf16 bf16x2_t __attribute__((ext_vector_type(2)));
DI unsigned cvt_pk_bf16(float lo, float hi) { const f32x2 f = {lo, hi}; return __builtin_bit_cast(unsigned, __builtin_convertvector(f, bf16x2_t)); }
DI float bf_lo(unsigned u) { return __uint_as_float(u << 16); }
DI float bf_hi(unsigned u) { return __uint_as_float(u & 0xffff0000u); }
DI float bf2f(unsigned short b) { return __uint_as_float(((unsigned)b) << 16); }
DI unsigned short f2bf(float f) { return (unsigned short)(cvt_pk_bf16(f, 0.f) & 0xffffu); }
DI float fast_exp(float x) { return __builtin_amdgcn_exp2f(x * 1.4426950408889634f); }
DI float fast_rcp(float x) { return __builtin_amdgcn_rcpf(x); }
DI float sigmoid_f(float x) { return fast_rcp(1.0f + fast_exp(-x)); }
DI float silu_f(float x) { return x * sigmoid_f(x); }
DI float gelu_tanh_f(float x) {
    const float u = 1.5957691216057308f * (x + 0.044715f * x * x * x);
    return x * sigmoid_f(u);
}
#define LDS_WAIT() asm volatile("s_waitcnt lgkmcnt(0)" ::: "memory")
#define VM_WAIT() asm volatile("s_waitcnt vmcnt(0)" ::: "memory")
#define MFMA16(a, b, c) __builtin_amdgcn_mfma_f32_16x16x32_bf16((a), (b), (c), 0, 0, 0)

namespace pg8 {
#define PG8_LAS __attribute__((address_space(3)))
constexpr int BM = 256, BK = 64, HALF = 128, HTB = HALF * BK * 2  , STAGE_BYTES = 8 * HTB, NXCD = 8, WGM = 8;
__host__ __device__ __forceinline__ int lds_byte(int r, int c) { const int st = (r >> 4) * 2 + (c >> 5), rr = r & 15, cc = c & 31, ob = rr * 64 + cc * 2; return st * 1024 + (ob ^ (((ob >> 9) & 1) << 5)); }
__host__ __device__ __forceinline__ void stage_rc(int b, int& R, int& C) { const int st = b / 1024, sb = b % 1024, swz = sb ^ (((sb >> 9) & 1) << 5); R = (st >> 1) * 16 + swz / 64; C = (st & 1) * 32 + (swz % 64) / 2; }
__host__ __device__ __forceinline__ int perm32(int rho) { const int n = rho >> 4, i = rho & 15; return 8 * (i >> 2) + 4 * n + (i & 3); }

struct Unit { int pm, pn, e; };

struct StaticOrder {
    const char* A; const char* Bt; int K; int nM, nN, nwg, G, c;
    __device__ void init(const void* A_, const void* Bt_, int M, int N, int K_, int G_, int c_) { A = (const char*)A_; Bt = (const char*)Bt_; K = K_; nM = M / BM; nN = N / BM; nwg = nM * nN; G = G_; c = c_; }
    __device__ __forceinline__ bool next(int i, Unit& u) const {
        const long L = (long)i * G + c; if (L >= nwg) return false;
        int wgid = (int)L; { const int q = nwg / NXCD, r = nwg % NXCD, xcd = wgid % NXCD, off = wgid / NXCD; wgid = (xcd < r ? xcd * (q + 1) : r * (q + 1) + (xcd - r) * q) + off; }
        const int nig = WGM * nN, gid = wgid / nig, fm = gid * WGM, gsz = (nM - fm) < WGM ? (nM - fm) : WGM;
        u.pm = fm + ((wgid % nig) % gsz); u.pn = (wgid % nig) / gsz; u.e = i; return true;
    }
    __device__ __forceinline__ const char* a_ptr(const Unit& u) const { return A + (size_t)u.pm * BM * K * 2; }
    __device__ __forceinline__ const char* b_ptr(const Unit& u) const { return Bt + (size_t)u.pn * BM * K * 2; }
    __device__ __forceinline__ void a_rows(const Unit&, const int (&)[2], const int (&)[2], unsigned (&)[2][2]) const {}
};
struct NoHook { static constexpr bool ACTIVE = false; __device__ __forceinline__ bool wants(int) const { return false; }
    __device__ __forceinline__ void apply(int, f32x4 (&)[2][2][4][2], const Unit&, int, int, int, int) const {} };

template <class Epi, class Sched, class Hook, bool GATHER, bool ALIGN_EPI, bool SP2>
__device__ __forceinline__ void gemm_phase(PG8_LAS unsigned char* lds, const int K, const Sched& S, const Epi& E, const Hook& H) {
    const int tid = threadIdx.x, wid = __builtin_amdgcn_readfirstlane(tid >> 6), lane = tid & 63, wr = wid >> 2, wc = wid & 3, fr = lane & 15, fq = lane >> 4;
    const int nt = K / BK, lda = K;
    unsigned voffA[2], voffB[2]; int RA[2], CA[2];
#pragma unroll
    for (int i = 0; i < 2; ++i) { int R, C; stage_rc(tid * 16 + i * 8192, R, C); const int Rb = Epi::PERM ? ((R & ~31) + perm32(R & 31)) : R;
        RA[i] = R; CA[i] = C * 2; voffA[i] = (unsigned)(R * lda + C) * 2u; voffB[i] = (unsigned)(Rb * K + C) * 2u; }
    const size_t kstep = (size_t)(BK * 2);
    const size_t hstep = (size_t)HALF * K * 2, hstepA = (size_t)HALF * lda * 2;
    const unsigned ldsw = (unsigned)wid * 1024u;
    const int aoff = lds_byte(wr * 64 + fr, fq * 8), boff = lds_byte(wc * 32 + fr, fq * 8);
#define PG8_SA(b, h) (((b) * 2 + (h)) * HTB)
#define PG8_SB(b, h) ((4 + (b) * 2 + (h)) * HTB)
#define PG8_STAGE2(bufoff, gbase, v0, v1) do { \
        __builtin_amdgcn_global_load_lds((const unsigned*)((const char*)(gbase) + (v0)), (PG8_LAS unsigned*)(lds + (bufoff) + ldsw), 16, 0, 0); \
        __builtin_amdgcn_global_load_lds((const unsigned*)((const char*)(gbase) + (v1)), (PG8_LAS unsigned*)(lds + (bufoff) + ldsw + 8192), 16, 0, 0); } while (0)
#define PG8_STAGE(bufoff, gbase, voff) PG8_STAGE2(bufoff, gbase, (voff)[0], (voff)[1])
#define PG8_STAGE_A(bufoff, abase, h, NXT) do { if constexpr (GATHER) { PG8_STAGE2(bufoff, abase, (NXT) ? gN[h][0] : gC[h][0], (NXT) ? gN[h][1] : gC[h][1]); } else { PG8_STAGE(bufoff, (abase) + (h) * hstepA, voffA); } } while (0)
#define PG8_LDA(dst, b, h) do { _Pragma("unroll") for (int m = 0; m < 4; ++m) _Pragma("unroll") for (int k = 0; k < 2; ++k) dst[m][k] = *(const PG8_LAS bf16x8*)(lds + PG8_SA(b, h) + aoff + m * 2048 + k * 1024); } while (0)
#define PG8_LDB(dst, b, h) do { _Pragma("unroll") for (int n = 0; n < 2; ++n) _Pragma("unroll") for (int k = 0; k < 2; ++k) dst[n][k] = *(const PG8_LAS bf16x8*)(lds + PG8_SB(b, h) + boff + n * 2048 + k * 1024); } while (0)
#define PG8_MMA(ai, bj, At, Bt) do { __builtin_amdgcn_s_setprio(1); _Pragma("unroll") for (int m = 0; m < 4; ++m) _Pragma("unroll") for (int n = 0; n < 2; ++n) _Pragma("unroll") for (int k = 0; k < 2; ++k) \
        acc[ai][bj][m][n] = __builtin_amdgcn_mfma_f32_16x16x32_bf16(Bt[n][k], At[m][k], acc[ai][bj][m][n], 0, 0, 0); __builtin_amdgcn_s_setprio(0); } while (0)
#define PG8_WAIT_V(n) asm volatile("s_waitcnt vmcnt(" #n ")" ::: "memory")
#define PG8_WAIT_L(n) asm volatile("s_waitcnt lgkmcnt(" #n ")" ::: "memory")
#define PG8_BAR __builtin_amdgcn_s_barrier()
#define PG8_SCHED __builtin_amdgcn_sched_barrier(0)
    Unit cur, nxt; int ui = 0;
    if (!S.next(0, cur)) return;
    f32x4 acc[2][2][4][2];
#pragma unroll
    for (int a = 0; a < 2; ++a)
#pragma unroll
        for (int b = 0; b < 2; ++b)
#pragma unroll
            for (int m = 0; m < 4; ++m)
#pragma unroll
                for (int n = 0; n < 2; ++n) acc[a][b][m][n] = (f32x4){0.f, 0.f, 0.f, 0.f};
    bf16x8 At[4][2], B0[2][2], B1[2][2];
    unsigned gC[2][2] = {{0u, 0u}, {0u, 0u}}, gN[2][2] = {{0u, 0u}, {0u, 0u}};
    const char* cA = S.a_ptr(cur); const char* cB = S.b_ptr(cur);
    if constexpr (GATHER) S.a_rows(cur, RA, CA, gC);
    if constexpr (SP2) {
        PG8_STAGE(PG8_SB(0, 0), cB, voffB); PG8_STAGE(PG8_SB(0, 1), cB + hstep, voffB); PG8_STAGE_A(PG8_SA(0, 0), cA, 0, false); PG8_STAGE_A(PG8_SA(0, 1), cA, 1, false);
        if (wr == 1) PG8_BAR;
        PG8_WAIT_V(2); PG8_BAR;
        PG8_STAGE(PG8_SB(1, 0), cB + kstep, voffB); PG8_STAGE_A(PG8_SA(1, 0), cA + kstep, 0, false); PG8_STAGE(PG8_SB(1, 1), cB + hstep + kstep, voffB);
        PG8_WAIT_V(6); PG8_BAR;
    } else {
        PG8_STAGE(PG8_SB(0, 0), cB, voffB); PG8_STAGE_A(PG8_SA(0, 0), cA, 0, false); PG8_STAGE(PG8_SB(0, 1), cB + hstep, voffB); PG8_STAGE_A(PG8_SA(0, 1), cA, 1, false);
        if (wr == 1) PG8_BAR;
        PG8_WAIT_V(4); PG8_BAR;
        PG8_STAGE(PG8_SB(1, 0), cB + kstep, voffB); PG8_STAGE_A(PG8_SA(1, 0), cA + kstep, 0, false); PG8_STAGE(PG8_SB(1, 1), cB + hstep + kstep, voffB);
        PG8_WAIT_V(6); PG8_BAR;
    }
    for (;;) {
        const bool has_next = S.next(ui + 1, nxt);
        const char* nA = has_next ? S.a_ptr(nxt) : cA; const char* nB = has_next ? S.b_ptr(nxt) : cB;
        if constexpr (GATHER) { if (has_next) S.a_rows(nxt, RA, CA, gN); else {
#pragma unroll
            for (int h = 0; h < 2; ++h) { gN[h][0] = gC[h][0]; gN[h][1] = gC[h][1]; } } }
        for (int t = 0; t < nt; t += 2) {
            const bool last = (t == nt - 2);
            const char* a1 = cA + (size_t)(t + 1) * kstep;
            const char* a2 = last ? nA : cA + (size_t)(t + 2) * kstep; const char* b2 = last ? nB : cB + (size_t)(t + 2) * kstep;
            const char* a3 = a2 + kstep; const char* b3 = b2 + kstep;
            if constexpr (Hook::ACTIVE) { if (H.wants(t)) H.apply(t, acc, cur, wr, wc, fr, fq); }
            if constexpr (SP2) {
            PG8_LDB(B0, 0, 0); PG8_LDB(B1, 0, 1); PG8_SCHED; PG8_LDA(At, 0, 0); PG8_STAGE_A(PG8_SA(1, 1), a1, 1, false);
            PG8_WAIT_V(8); PG8_WAIT_L(0); PG8_BAR; PG8_MMA(0, 0, At, B0); PG8_MMA(0, 1, At, B1); PG8_BAR; PG8_SCHED;
            PG8_LDA(At, 0, 1); PG8_STAGE(PG8_SB(0, 0), b2, voffB); PG8_STAGE(PG8_SB(0, 1), b2 + hstep, voffB); PG8_STAGE_A(PG8_SA(0, 0), a2, 0, last);
            PG8_WAIT_V(8); PG8_WAIT_L(0); PG8_BAR; PG8_MMA(1, 0, At, B0); PG8_MMA(1, 1, At, B1); PG8_BAR; PG8_SCHED;
            PG8_LDB(B0, 1, 0); PG8_LDB(B1, 1, 1); PG8_SCHED; PG8_LDA(At, 1, 0); PG8_STAGE_A(PG8_SA(0, 1), a2, 1, last);
            PG8_WAIT_V(8); PG8_WAIT_L(0); PG8_BAR; PG8_MMA(0, 0, At, B0); PG8_MMA(0, 1, At, B1); PG8_BAR; PG8_SCHED;
            PG8_LDA(At, 1, 1); PG8_STAGE(PG8_SB(1, 0), b3, voffB); PG8_STAGE(PG8_SB(1, 1), b3 + hstep, voffB); PG8_STAGE_A(PG8_SA(1, 0), a3, 0, last);
            PG8_WAIT_V(8); PG8_WAIT_L(0); PG8_BAR; PG8_MMA(1, 0, At, B0); PG8_MMA(1, 1, At, B1); PG8_BAR; PG8_SCHED;
            } else {
            PG8_LDB(B0, 0, 0); PG8_SCHED; PG8_LDA(At, 0, 0); PG8_STAGE_A(PG8_SA(1, 1), a1, 1, false);
            PG8_WAIT_L(8); PG8_BAR; PG8_WAIT_L(0); PG8_MMA(0, 0, At, B0); PG8_BAR; PG8_SCHED;
            PG8_LDB(B1, 0, 1); PG8_STAGE(PG8_SB(0, 0), b2, voffB);
            PG8_BAR; PG8_WAIT_L(0); PG8_MMA(0, 1, At, B1); PG8_BAR;
            PG8_LDA(At, 0, 1); PG8_STAGE_A(PG8_SA(0, 0), a2, 0, last);
            PG8_BAR; PG8_WAIT_L(0); PG8_MMA(1, 0, At, B0); PG8_BAR; PG8_SCHED;
            PG8_STAGE(PG8_SB(0, 1), b2 + hstep, voffB);
            PG8_WAIT_V(6); PG8_BAR; PG8_MMA(1, 1, At, B1); PG8_BAR;
            PG8_LDB(B0, 1, 0); PG8_SCHED; PG8_LDA(At, 1, 0); PG8_STAGE_A(PG8_SA(0, 1), a2, 1, last);
            PG8_WAIT_L(8); PG8_BAR; PG8_WAIT_L(0); PG8_MMA(0, 0, At, B0); PG8_BAR; PG8_SCHED;
            PG8_LDB(B1, 1, 1); PG8_STAGE(PG8_SB(1, 0), b3, voffB);
            PG8_BAR; PG8_WAIT_L(0); PG8_MMA(0, 1, At, B1); PG8_BAR;
            PG8_LDA(At, 1, 1); PG8_STAGE_A(PG8_SA(1, 0), a3, 0, last);
            PG8_BAR; PG8_WAIT_L(0); PG8_MMA(1, 0, At, B0); PG8_BAR; PG8_SCHED;
            PG8_STAGE(PG8_SB(1, 1), b3 + hstep, voffB);
            PG8_WAIT_V(6); PG8_BAR; PG8_MMA(1, 1, At, B1); PG8_BAR;
            }
        }
        if constexpr (ALIGN_EPI) { if (wr == 0) PG8_BAR; }
        E(acc, cur, wr, wc, fr, fq);
        if (!has_next) break;
#pragma unroll
        for (int a = 0; a < 2; ++a)
#pragma unroll
            for (int b = 0; b < 2; ++b)
#pragma unroll
                for (int m = 0; m < 4; ++m)
#pragma unroll
                    for (int n = 0; n < 2; ++n) acc[a][b][m][n] = (f32x4){0.f, 0.f, 0.f, 0.f};
        cur = nxt; cA = nA; cB = nB; ++ui;
        if constexpr (GATHER) {
#pragma unroll
            for (int h = 0; h < 2; ++h) { gC[h][0] = gN[h][0]; gC[h][1] = gN[h][1]; } }
        if constexpr (ALIGN_EPI) { if (wr == 1) PG8_BAR; }
    }
    PG8_WAIT_V(0);
    if constexpr (!ALIGN_EPI) { if (wr == 0) PG8_BAR; }
    PG8_BAR;
#undef PG8_SA
#undef PG8_SB
#undef PG8_STAGE
#undef PG8_STAGE2
#undef PG8_STAGE_A
#undef PG8_LDA
#undef PG8_LDB
#undef PG8_MMA
#undef PG8_WAIT_V
#undef PG8_WAIT_L
#undef PG8_BAR
#undef PG8_SCHED
}
}

constexpr int NB = 16, SEQ = 2048, D = 1024, NTOK = NB * SEQ;
constexpr int IN_COLS = 7184, NPROJ = 7168, ALR_COL = 5120;
constexpr int NEXP = 32, FF = 512, NWAVES = 8;
constexpr float DN_ALPHA = 1.189207115002721f, LN_EPS = 1e-5f, RMS_EPS = 1e-6f, QSCALE = 0.08838834764831845f;
constexpr int MAXROWS = 2 * NTOK + NEXP * 256;

constexpr size_t MiB = 1u << 20;
constexpr size_t WS_CTL = 0, CTL_ZERO_BYTES = 1 * MiB;
constexpr size_t WS_RGT = 1 * MiB;
constexpr size_t WS_TOKE = 1 * MiB + 512 * 1024;
constexpr size_t WS_TOKW = WS_TOKE + 256 * 1024;
constexpr size_t WS_ALR = 2 * MiB;
constexpr size_t WS_WR = 4 * MiB, WS_WG = 6 * MiB, WS_WO = 8 * MiB;
constexpr size_t WS_RX = 10 * MiB, WS_RY = 74 * MiB, WS_Q = 138 * MiB, WS_K = 170 * MiB, WS_V = 202 * MiB, WS_G = 266 * MiB;
constexpr size_t WS_E13 = 330 * MiB, WS_E2 = 394 * MiB;
constexpr size_t WS_XB = 426 * MiB, WS_WIN = 490 * MiB;
constexpr size_t WS_ORAW = 426 * MiB, WS_PBUF = 490 * MiB, WS_DEC = 506 * MiB, WS_SSQ = 507 * MiB;
constexpr size_t WS_ROWS = 511 * MiB;
constexpr size_t WS_MERGED = 202 * MiB;
constexpr size_t WS_Z1 = 266 * MiB;
constexpr size_t WS_TMP = 138 * MiB;
constexpr size_t WS_X1B = 10 * MiB;
constexpr size_t WS_H = 74 * MiB;
constexpr size_t WS_SLOTS = 146 * MiB;
constexpr size_t WS_END = 512 * MiB;
static_assert(WS_H + (size_t)MAXROWS * FF * 2 <= WS_SLOTS && WS_SLOTS + (size_t)2 * NTOK * D * 2 <= WS_E13 && WS_ROWS + 3 * (size_t)MAXROWS * 4 <= WS_END, "d_ws map");
constexpr int CW_BAR = 4096;
constexpr int CW_TS = 8192;
constexpr int CW_WGCNT = 131072;

constexpr int RING_BYTES = 131072, AUX_OFF = 131072, LDSCTL_OFF = 150528, LDS_BYTES = 151552;

#define XB_TMO      128
#define XB_XCNT(j)  (256  + 64 * (j))
#define XB_XSUB(j)  (1280 + 64 * (j))
#define XB_XGEN(j)  (2304 + 64 * (j))
#define XB_TOP      3328
#define XB_TOPGEN   3392
#define XCD_BAR_WORDS 3456
#define XB_SPIN_CAP (1u << 18)
__device__ __forceinline__ unsigned xb_ld(unsigned* p)              { return __hip_atomic_load(p, __ATOMIC_RELAXED, __HIP_MEMORY_SCOPE_AGENT); }
__device__ __forceinline__ unsigned xb_add(unsigned* p, unsigned v) { return __hip_atomic_fetch_add(p, v, __ATOMIC_RELAXED, __HIP_MEMORY_SCOPE_AGENT); }
__device__ __forceinline__ unsigned xb_xcc_id() { return (unsigned)__builtin_amdgcn_s_getreg((3 << 11) | 20) & 0xFu; }
#define XB_SPIN(cond, bar) do { unsigned _sp = 0; while (cond) { __builtin_amdgcn_s_sleep(1); \
    if ((++_sp & 255u) == 0u) { if (xb_ld(&(bar)[XB_TMO])) break; if (_sp > XB_SPIN_CAP) { atomicAdd(&(bar)[XB_TMO], 1u); break; } } } } while (0)
struct XcdBarrier { unsigned* bar; unsigned x; volatile LAS unsigned* st; };
__device__ __forceinline__ XcdBarrier xcd_barrier_post(unsigned* bar, volatile LAS unsigned* st) {
    XcdBarrier b; b.bar = bar; b.x = xb_xcc_id(); b.st = st;
    if (threadIdx.x == 0) (void)xb_add(&bar[XB_XCNT(b.x)], 1u);
    return b;
}
__device__ __forceinline__ void xcd_barrier_complete(unsigned* bar, unsigned x, unsigned& nloc, unsigned& nx) {
    const unsigned G = gridDim.x * gridDim.y * gridDim.z;
    unsigned sum, cnt, mine, sp = 0u;
    for (;;) {
        sum = 0u; cnt = 0u; mine = 0u;
#pragma unroll
        for (unsigned j = 0; j < 16; ++j) { const unsigned c = xb_ld(&bar[XB_XCNT(j)]); sum += c; cnt += (c > 0u) ? 1u : 0u; mine = (j == x) ? c : mine; }
        if (sum == G) break;
        __builtin_amdgcn_s_sleep(1);
        if ((++sp & 255u) == 0u) { if (xb_ld(&bar[XB_TMO])) break; if (sp > XB_SPIN_CAP) { atomicAdd(&bar[XB_TMO], 1u); break; } }
    }
    nloc = mine > 0u ? mine : 1u; nx = cnt > 0u ? cnt : 1u;
}
__device__ __forceinline__ void xcd_barrier(const XcdBarrier& b) {
    asm volatile("s_waitcnt vmcnt(0)" ::: "memory");
    __syncthreads();
    if (threadIdx.x == 0) {
        unsigned* bar = b.bar;
        __builtin_amdgcn_s_waitcnt(0);
        unsigned nloc = b.st[0], nx = b.st[1];
        if (nloc == 0u) { xcd_barrier_complete(bar, b.x, nloc, nx); b.st[0] = nloc; b.st[1] = nx; }
        const unsigned old = xb_add(&bar[XB_XSUB(b.x)], 1u);
        const unsigned gen = old / nloc;
        if (old + 1u == (gen + 1u) * nloc) {
            __builtin_amdgcn_fence(__ATOMIC_RELEASE, "agent");
            asm volatile("s_waitcnt vmcnt(0)" ::: "memory");
            const unsigned og = xb_add(&bar[XB_TOP], 1u);
            const unsigned tg = og / nx;
            if (og + 1u == (tg + 1u) * nx) xb_add(&bar[XB_TOPGEN], 1u);
            else XB_SPIN(xb_ld(&bar[XB_TOPGEN]) == tg, bar);
            __builtin_amdgcn_fence(__ATOMIC_ACQUIRE, "agent");
            xb_add(&bar[XB_XGEN(b.x)], 1u);
            asm volatile("s_waitcnt vmcnt(0)" ::: "memory");
        } else {
            XB_SPIN(xb_ld(&bar[XB_XGEN(b.x)]) == gen, bar);
            __builtin_amdgcn_fence(__ATOMIC_ACQUIRE, "agent");
            asm volatile("s_waitcnt vmcnt(0)" ::: "memory");
        }
    }
    __syncthreads();
}

struct Frame {
    LAS unsigned char* lds;
    unsigned* ctl;
    int tid, lane, wave, vcu, G;
    float* out;
    unsigned char* ws;
};
struct Args { const float* in[28]; float* out; unsigned char* ws; int ph_lo, ph_hi, dup, pad; };
enum InIdx { I_X = 0, I_WIN, I_BIN, I_CONVW, I_CONVB, I_RGWA, I_RGBA, I_RGWX, I_RGBX, I_LAM, I_GWA2, I_GBA, I_GNORM, I_WPR, I_WPG, I_WO, I_BO, I_LN1G, I_LN1B,
             I_RWG, I_RBG, I_RWE, I_RBE, I_EW1, I_EW3, I_EW2, I_LN2G, I_LN2B };
template <class T> DI T* wsp(Frame& F, size_t off) { return (T*)(F.ws + off); }

template <int CTRL, int RM> DI float dpp_mov0(float v) { return __builtin_bit_cast(float, __builtin_amdgcn_update_dpp(0, __builtin_bit_cast(int, v), CTRL, RM, 0xF, false)); }
DI float wave_sum(float v) {
    v += dpp_mov0<0xB1, 0xF>(v);
    v += dpp_mov0<0x4E, 0xF>(v);
    v += dpp_mov0<0x141, 0xF>(v);
    v += dpp_mov0<0x140, 0xF>(v);
    v += dpp_mov0<0x142, 0xA>(v);
    v += dpp_mov0<0x143, 0xC>(v);
    return __builtin_bit_cast(float, __builtin_amdgcn_readlane(__builtin_bit_cast(int, v), 63));
}
DI int idx16(int lane) { return ((lane >> 5) & 1) * 8 + ((lane >> 4) & 1) * 4 + ((lane >> 3) & 1) * 2 + ((lane >> 2) & 1); }
DI float reduce16(const float (&a)[16], int lane) {
    float b[8], c[4], d[2];
    { const bool hi = (lane & 32) != 0;
#pragma unroll
      for (int i = 0; i < 8; ++i) { const float keep = hi ? a[i + 8] : a[i], send = hi ? a[i] : a[i + 8]; b[i] = keep + __shfl_xor(send, 32); } }
    { const bool hi = (lane & 16) != 0;
#pragma unroll
      for (int i = 0; i < 4; ++i) { const float keep = hi ? b[i + 4] : b[i], send = hi ? b[i] : b[i + 4]; c[i] = keep + __shfl_xor(send, 16); } }
    { const bool hi = (lane & 8) != 0;
#pragma unroll
      for (int i = 0; i < 2; ++i) { const float keep = hi ? c[i + 2] : c[i], send = hi ? c[i] : c[i + 2]; d[i] = keep + __shfl_xor(send, 8); } }
    float e; { const bool hi = (lane & 4) != 0; const float keep = hi ? d[1] : d[0], send = hi ? d[0] : d[1]; e = keep + __shfl_xor(send, 4); }
    e += __shfl_xor(e, 2); e += __shfl_xor(e, 1);
    return e;
}

DI void transpose_item(const float* src, int ld_src, bf16_t* dst, int ld_dst, LAS float* scr, int lane) {
    f32x4 v[8];
#pragma unroll
    for (int i = 0; i < 8; ++i) v[i] = *(const f32x4*)(src + (size_t)((lane >> 3) + 8 * i) * ld_src + 4 * (lane & 7));
#pragma unroll
    for (int i = 0; i < 8; ++i) { LAS float* p = scr + ((lane >> 3) + 8 * i) * 33 + 4 * (lane & 7); p[0] = v[i].x; p[1] = v[i].y; p[2] = v[i].z; p[3] = v[i].w; }
    LDS_WAIT(); asm volatile("" ::: "memory");
    const int c = lane & 7;
#pragma unroll
    for (int j = 0; j < 4; ++j) { const int n = (lane >> 3) + 8 * j; const LAS float* s = scr + (8 * c) * 33 + n;
        u32x4 o; o.x = cvt_pk_bf16(s[0 * 33], s[1 * 33]); o.y = cvt_pk_bf16(s[2 * 33], s[3 * 33]); o.z = cvt_pk_bf16(s[4 * 33], s[5 * 33]); o.w = cvt_pk_bf16(s[6 * 33], s[7 * 33]);
        *(u32x4*)(dst + (size_t)n * ld_dst + 8 * c) = o; }
    LDS_WAIT(); asm volatile("" ::: "memory");
}
DI void p0_prologue(Frame& F, const Args& A) {
    LAS float* scr = (LAS float*)(F.lds + F.wave * 8704);
    LAS float* walr = (LAS float*)(F.lds + 81920);
    const int gw = F.vcu * NWAVES + F.wave, NGW = F.G * NWAVES, lane = F.lane;
    const float* w_in = A.in[I_WIN];
    for (int i = F.tid; i < 16 * 1024; i += NWAVES * 64) { const int k = i >> 4, r = i & 15; walr[r * 1028 + k] = w_in[(size_t)k * IN_COLS + ALR_COL + r]; }
    __syncthreads();
    constexpr int N_WIN = 16 * 224, N_SQ = 3 * 512, N_RG = 128, N_E13 = 32 * 512, N_E2 = 32 * 256;
    constexpr int NITEMS = N_WIN + N_SQ + N_RG + N_E13 + N_E2;
    for (int rep_ = 0; rep_ < 1 + ((MK_DUP >> 13) & 1); ++rep_)
    for (int it0 = gw; it0 < NITEMS; it0 += NGW) {
        int it = it0;
        if (it < N_WIN) { const int kb = it / 224, nb = it % 224, n0 = 32 * nb, sc = n0 + (n0 >= ALR_COL ? 16 : 0);
            transpose_item(w_in + (size_t)(64 * kb) * IN_COLS + sc, IN_COLS, wsp<bf16_t>(F, WS_WIN) + (size_t)n0 * 1024 + 64 * kb, 1024, scr, lane); continue; }
        it -= N_WIN;
        if (it < N_SQ) { const int mat = it / 512, r = it % 512, kb = r / 32, nb = r % 32;
            const size_t so = (size_t)(64 * kb) * 1024 + 32 * nb, dof = (size_t)(32 * nb) * 1024 + 64 * kb;
            if (mat == 0) transpose_item(A.in[I_WPR] + so, 1024, wsp<bf16_t>(F, WS_WR) + dof, 1024, scr, lane);
            else if (mat == 1) transpose_item(A.in[I_WPG] + so, 1024, wsp<bf16_t>(F, WS_WG) + dof, 1024, scr, lane);
            else transpose_item(A.in[I_WO] + so, 1024, wsp<bf16_t>(F, WS_WO) + dof, 1024, scr, lane);
            continue; }
        it -= N_SQ;
        if (it < N_RG) { const int bg = it / 8, r = it % 8, kb = r / 4, nb = r % 4, blk = bg >> 1, gate = bg & 1;
            const size_t so = (size_t)blk * 16384 + (64 * kb) * 128 + 32 * nb; bf16_t* dp = wsp<bf16_t>(F, WS_RGT) + (size_t)bg * 16384 + (32 * nb) * 128 + 64 * kb;
            if (gate) transpose_item(A.in[I_RGWX] + so, 128, dp, 128, scr, lane); else transpose_item(A.in[I_RGWA] + so, 128, dp, 128, scr, lane);
            continue; }
        it -= N_RG;
        if (it < N_E13) { const int e = it / 512, r = it % 512, which = r / 256, r2 = r % 256, kb = r2 / 16, nb = r2 % 16, n0 = 32 * nb;
            const int nd = 256 * (n0 / 128) + 128 * which + (n0 % 128);
            const size_t so = (size_t)e * (1024 * 512) + (size_t)(64 * kb) * 512 + n0; bf16_t* dp = wsp<bf16_t>(F, WS_E13) + (size_t)e * (1024 * 1024) + (size_t)nd * 1024 + 64 * kb;
            if (which) transpose_item(A.in[I_EW3] + so, 512, dp, 1024, scr, lane); else transpose_item(A.in[I_EW1] + so, 512, dp, 1024, scr, lane);
            continue; }
        it -= N_E13;
        { const int e = it / 256, r = it % 256, kb = r / 32, nb = r % 32;
            const float* W = A.in[I_EW2] + (size_t)e * (512 * 1024);
            transpose_item(W + (size_t)(64 * kb) * 1024 + 32 * nb, 1024, wsp<bf16_t>(F, WS_E2) + (size_t)e * (1024 * 512) + (size_t)(32 * nb) * 512 + 64 * kb, 512, scr, lane); }
    }
    const float* x = A.in[I_X]; bf16_t* xb = wsp<bf16_t>(F, WS_XB); float* alr = wsp<float>(F, WS_ALR);
    const float balr = A.in[I_BIN][ALR_COL + idx16(lane)];
    for (int rep_ = 0; rep_ < 1 + ((MK_DUP >> 14) & 1); ++rep_)
    for (int m = 2 * gw; m < NTOK; m += 2 * NGW) {
        f32x4 xv[2][4];
#pragma unroll
        for (int r = 0; r < 2; ++r)
#pragma unroll
            for (int j = 0; j < 4; ++j) xv[r][j] = *((const f32x4*)(x + (size_t)(m + r) * D) + lane + 64 * j);
#pragma unroll
        for (int r = 0; r < 2; ++r)
#pragma unroll
            for (int j = 0; j < 4; ++j) { u32x2 w; w.x = cvt_pk_bf16(xv[r][j].x, xv[r][j].y); w.y = cvt_pk_bf16(xv[r][j].z, xv[r][j].w);
                *(u32x2*)(xb + (size_t)(m + r) * D + 4 * lane + 256 * j) = w; }
        float a0[16], a1[16];
#pragma unroll
        for (int rr = 0; rr < 16; ++rr) { a0[rr] = 0.f; a1[rr] = 0.f; }
#pragma unroll
        for (int j = 0; j < 4; ++j) {
#pragma unroll
            for (int rr = 0; rr < 16; ++rr) { const f32x4 wv = *(const LAS f32x4*)(walr + rr * 1028 + 256 * j + 4 * lane);
                a0[rr] += xv[0][j].x * wv.x + xv[0][j].y * wv.y + xv[0][j].z * wv.z + xv[0][j].w * wv.w;
                a1[rr] += xv[1][j].x * wv.x + xv[1][j].y * wv.y + xv[1][j].z * wv.z + xv[1][j].w * wv.w; }
            __builtin_amdgcn_sched_barrier(0); }
        const float t0 = reduce16(a0, lane) + balr, t1 = reduce16(a1, lane) + balr;
        if ((lane & 3) == 0) { alr[(size_t)m * 16 + idx16(lane)] = t0; alr[(size_t)(m + 1) * 16 + idx16(lane)] = t1; }
    }
}

using pg8::Unit;
struct EpiProj {
    static constexpr bool PERM = true;
    bf16_t *rx, *ry, *q, *k, *v, *g, *ga, *gb; const float* bias;
    DI void operator()(const f32x4 (&acc)[2][2][4][2], const Unit& u, int wr, int wc, int fr, int fq) const {
        const int pn = u.pn; bf16_t* base; int ldc = 1024, ct;
        if (pn < 4) { base = rx; ct = pn; } else if (pn < 8) { base = ry; ct = pn - 4; } else if (pn < 10) { base = q; ldc = 512; ct = pn - 8; } else if (pn < 12) { base = k; ldc = 512; ct = pn - 10; }
        else if (pn < 16) { base = v; ct = pn - 12; } else if (pn < 20) { base = g; ct = pn - 16; } else if (pn < 24) { base = ga; ct = pn - 20; } else { base = gb; ct = pn - 24; }
        const int row0 = u.pm * 256 + wr * 64 + fr, col0 = ct * 256 + wc * 32 + 8 * fq, bcol0 = pn * 256 + (pn >= 20 ? 16 : 0) + wc * 32 + 8 * fq;
        f32x4 bv[2][2];
#pragma unroll
        for (int bj = 0; bj < 2; ++bj)
#pragma unroll
            for (int n = 0; n < 2; ++n) bv[bj][n] = *(const f32x4*)(bias + bcol0 + bj * 128 + 4 * n);
#pragma unroll
        for (int ai = 0; ai < 2; ++ai)
#pragma unroll
            for (int m = 0; m < 4; ++m) { bf16_t* rowp = base + (size_t)(row0 + ai * 128 + m * 16) * ldc + col0;
#pragma unroll
                for (int bj = 0; bj < 2; ++bj) { const f32x4 v0 = acc[ai][bj][m][0] + bv[bj][0], v1 = acc[ai][bj][m][1] + bv[bj][1];
                    u32x4 w; w.x = cvt_pk_bf16(v0[0], v0[1]); w.y = cvt_pk_bf16(v0[2], v0[3]); w.z = cvt_pk_bf16(v1[0], v1[1]); w.w = cvt_pk_bf16(v1[2], v1[3]);
                    *(u32x4*)(rowp + bj * 128) = w; } }
    }
};
DI void unpack8(const u32x4 w, float (&f)[8]) { f[0] = bf_lo(w.x); f[1] = bf_hi(w.x); f[2] = bf_lo(w.y); f[3] = bf_hi(w.y); f[4] = bf_lo(w.z); f[5] = bf_hi(w.z); f[6] = bf_lo(w.w); f[7] = bf_hi(w.w); }
struct EpiMergeA {
    static constexpr bool PERM = true;
    const bf16_t* ga; bf16_t* tmp;
    DI void operator()(const f32x4 (&acc)[2][2][4][2], const Unit& u, int wr, int wc, int fr, int fq) const {
        const int row0 = u.pm * 256 + wr * 64 + fr, col0 = u.pn * 256 + wc * 32 + 8 * fq;
#pragma unroll
        for (int ai = 0; ai < 2; ++ai)
#pragma unroll
            for (int m = 0; m < 4; ++m) { const size_t off = (size_t)(row0 + ai * 128 + m * 16) * D + col0;
#pragma unroll
                for (int bj = 0; bj < 2; ++bj) { float gf[8]; unpack8(*(const u32x4*)(ga + off + bj * 128), gf);
                    f32x4 o0, o1;
#pragma unroll
                    for (int j = 0; j < 4; ++j) { o0[j] = sigmoid_f(gf[j]) * acc[ai][bj][m][0][j]; o1[j] = sigmoid_f(gf[4 + j]) * acc[ai][bj][m][1][j]; }
                    u32x4 w; w.x = cvt_pk_bf16(o0[0], o0[1]); w.y = cvt_pk_bf16(o0[2], o0[3]); w.z = cvt_pk_bf16(o1[0], o1[1]); w.w = cvt_pk_bf16(o1[2], o1[3]);
                    *(u32x4*)(tmp + off + bj * 128) = w; } }
    }
};
struct RowHook { static constexpr bool ACTIVE = true;
    const LAS float* rs;
    DI bool wants(int t) const { return t == 4 || t == 8 || t == 12; }
    DI void apply(int t, f32x4 (&acc)[2][2][4][2], const Unit& u, int wr, int wc, int fr, int fq) const {
        const int h = t >> 2;
#pragma unroll
        for (int ai = 0; ai < 2; ++ai)
#pragma unroll
            for (int m = 0; m < 4; ++m) { const f32x4 r4 = *(const LAS f32x4*)(rs + ((u.e & 1) * 256 + ai * 128 + wr * 64 + m * 16 + fr) * 4);
                const float f = (h == 1 ? r4[0] : (h == 2 ? r4[1] : r4[2])) * fast_rcp(h == 1 ? r4[1] : (h == 2 ? r4[2] : r4[3]));
#pragma unroll
                for (int bj = 0; bj < 2; ++bj) { acc[ai][bj][m][0] = acc[ai][bj][m][0] * f; acc[ai][bj][m][1] = acc[ai][bj][m][1] * f; } }
    }
};
struct EpiMergeB {
    static constexpr bool PERM = true;
    const bf16_t* gb; const bf16_t* tmp; bf16_t* merged; const LAS float* rs;
    DI void operator()(const f32x4 (&acc)[2][2][4][2], const Unit& u, int wr, int wc, int fr, int fq) const {
        const int row0 = u.pm * 256 + wr * 64 + fr, col0 = u.pn * 256 + wc * 32 + 8 * fq;
#pragma unroll
        for (int ai = 0; ai < 2; ++ai)
#pragma unroll
            for (int m = 0; m < 4; ++m) { const size_t off = (size_t)(row0 + ai * 128 + m * 16) * D + col0; const float rl = rs[((u.e & 1) * 256 + ai * 128 + wr * 64 + m * 16 + fr) * 4 + 3];
#pragma unroll
                for (int bj = 0; bj < 2; ++bj) { float gf[8], tf[8]; unpack8(*(const u32x4*)(gb + off + bj * 128), gf); unpack8(*(const u32x4*)(tmp + off + bj * 128), tf);
                    f32x4 o0, o1;
#pragma unroll
                    for (int j = 0; j < 4; ++j) { o0[j] = tf[j] + acc[ai][bj][m][0][j] * sigmoid_f(gf[j]) * rl; o1[j] = tf[4 + j] + acc[ai][bj][m][1][j] * sigmoid_f(gf[4 + j]) * rl; }
                    u32x4 w; w.x = cvt_pk_bf16(o0[0], o0[1]); w.y = cvt_pk_bf16(o0[2], o0[3]); w.z = cvt_pk_bf16(o1[0], o1[1]); w.w = cvt_pk_bf16(o1[2], o1[3]);
                    *(u32x4*)(merged + off + bj * 128) = w; } }
    }
};
struct EpiWo {
    static constexpr bool PERM = true;
    const bf16_t* xb; const float* bo; bf16_t* z;
    DI void operator()(const f32x4 (&acc)[2][2][4][2], const Unit& u, int wr, int wc, int fr, int fq) const {
        const int row0 = u.pm * 256 + wr * 64 + fr, col0 = u.pn * 256 + wc * 32 + 8 * fq;
        f32x4 bv[2][2];
#pragma unroll
        for (int bj = 0; bj < 2; ++bj)
#pragma unroll
            for (int n = 0; n < 2; ++n) bv[bj][n] = *(const f32x4*)(bo + col0 + bj * 128 + 4 * n);
#pragma unroll
        for (int ai = 0; ai < 2; ++ai)
#pragma unroll
            for (int m = 0; m < 4; ++m) { const size_t off = (size_t)(row0 + ai * 128 + m * 16) * D + col0;
#pragma unroll
                for (int bj = 0; bj < 2; ++bj) { float xf[8]; unpack8(*(const u32x4*)(xb + off + bj * 128), xf);
                    f32x4 o0, o1;
#pragma unroll
                    for (int j = 0; j < 4; ++j) { o0[j] = xf[j] * DN_ALPHA + acc[ai][bj][m][0][j] + bv[bj][0][j]; o1[j] = xf[4 + j] * DN_ALPHA + acc[ai][bj][m][1][j] + bv[bj][1][j]; }
                    u32x4 w; w.x = cvt_pk_bf16(o0[0], o0[1]); w.y = cvt_pk_bf16(o0[2], o0[3]); w.z = cvt_pk_bf16(o1[0], o1[1]); w.w = cvt_pk_bf16(o1[2], o1[3]);
                    *(u32x4*)(z + off + bj * 128) = w; } }
    }
};
struct EpiExp1 {
    static constexpr bool PERM = true;
    bf16_t* h;
    DI void operator()(const f32x4 (&acc)[2][2][4][2], const Unit& u, int wr, int wc, int fr, int fq) const {
        const int row0 = u.pm * 256 + wr * 64 + fr, col0 = u.pn * 128 + wc * 32 + 8 * fq;
#pragma unroll
        for (int ai = 0; ai < 2; ++ai)
#pragma unroll
            for (int m = 0; m < 4; ++m) { f32x4 o0, o1;
#pragma unroll
                for (int j = 0; j < 4; ++j) { o0[j] = silu_f(acc[ai][0][m][0][j]) * acc[ai][1][m][0][j]; o1[j] = silu_f(acc[ai][0][m][1][j]) * acc[ai][1][m][1][j]; }
                u32x4 w; w.x = cvt_pk_bf16(o0[0], o0[1]); w.y = cvt_pk_bf16(o0[2], o0[3]); w.z = cvt_pk_bf16(o1[0], o1[1]); w.w = cvt_pk_bf16(o1[2], o1[3]);
                *(u32x4*)(h + (size_t)(row0 + ai * 128 + m * 16) * FF + col0) = w; }
    }
};
struct EpiExp2 {
    static constexpr bool PERM = true;
    const int* row_slot; const float* row_w; bf16_t* slots;
    DI void operator()(const f32x4 (&acc)[2][2][4][2], const Unit& u, int wr, int wc, int fr, int fq) const {
        const int row0 = u.pm * 256 + wr * 64 + fr, col0 = u.pn * 256 + wc * 32 + 8 * fq;
#pragma unroll
        for (int ai = 0; ai < 2; ++ai)
#pragma unroll
            for (int m = 0; m < 4; ++m) { const int r = row0 + ai * 128 + m * 16; const int slot = row_slot[r]; const float w8 = row_w[r];
                if (slot >= 0) {
#pragma unroll
                    for (int bj = 0; bj < 2; ++bj) { const f32x4 v0 = acc[ai][bj][m][0] * w8, v1 = acc[ai][bj][m][1] * w8;
                        u32x4 w; w.x = cvt_pk_bf16(v0[0], v0[1]); w.y = cvt_pk_bf16(v0[2], v0[3]); w.z = cvt_pk_bf16(v1[0], v1[1]); w.w = cvt_pk_bf16(v1[2], v1[3]);
                        *(u32x4*)(slots + (size_t)slot * D + col0 + bj * 128) = w; } } }
    }
};
struct MoeOrder {
    const char* A; const char* Bt; int K; size_t bstride; const LAS int* ts; const int* row_tok; int G, c, gather;
    DI bool next(int i, Unit& u) const {
        const int L = i * G + c, ntile = ts[32]; if (L >= 4 * ntile) return false;
        const int tile = L >> 2, lane = threadIdx.x & 63;
        const int v = ts[lane < 32 ? lane + 1 : 32];
        const unsigned long long mk = __ballot(lane < 32 && v <= tile);
        u.pm = tile; u.pn = L & 3; u.e = __builtin_amdgcn_readfirstlane((int)__popcll(mk)); return true;
    }
    DI const char* a_ptr(const Unit& u) const { return gather ? A : A + (size_t)u.pm * 256 * K * 2; }
    DI const char* b_ptr(const Unit& u) const { return Bt + (size_t)u.e * bstride + (size_t)u.pn * 256 * K * 2; }
    DI void a_rows(const Unit& u, const int (&RA)[2], const int (&CA)[2], unsigned (&g)[2][2]) const {
#pragma unroll
        for (int h = 0; h < 2; ++h)
#pragma unroll
            for (int i = 0; i < 2; ++i) g[h][i] = (unsigned)row_tok[u.pm * 256 + h * 128 + RA[i]] * (unsigned)(K * 2) + (unsigned)CA[i];
    }
};

DI void phase_gla_pre(Frame& F, const Args& A, const bool dry) {
    LAS unsigned char* L = F.lds;
    constexpr int oQT = 0, oKT = 17408, oKE = 34816, oALR = 52224, oSEG = 56320, RS = 272;
    const int tid = F.tid, lane = F.lane, w = F.wave, kk = tid & 127, seg = tid >> 7, g = lane >> 4, fr = lane & 15;
    bf16_t* Q = wsp<bf16_t>(F, WS_Q); bf16_t* K = wsp<bf16_t>(F, WS_K); const float* ALR = wsp<float>(F, WS_ALR);
    bf16_t* PB = wsp<bf16_t>(F, WS_PBUF); float* DEC = wsp<float>(F, WS_DEC);
    for (int item = F.vcu; item < NB * 4 * 32; item += F.G) {
        const int b = item >> 7, hd = (item >> 5) & 3, n = item & 31;
        const size_t tok0 = (size_t)b * SEQ + n * 64;
        float w2[16];
#pragma unroll
        for (int r = 0; r < 16; ++r) w2[r] = A.in[I_GWA2][r * 512 + hd * 128 + kk];
        const float ba = A.in[I_GBA][hd * 128 + kk];
        __syncthreads();
#pragma unroll
        for (int c = tid; c < 1024; c += 512) { const int row = c >> 4, c16 = c & 15; const size_t go = (tok0 + row) * 512 + hd * 128 + c16 * 8;
            *(LAS u32x4*)(L + oQT + row * RS + c16 * 16) = *(const u32x4*)(Q + go); *(LAS u32x4*)(L + oKT + row * RS + c16 * 16) = *(const u32x4*)(K + go); }
        if (tid < 256) *(LAS f32x4*)(L + oALR + tid * 16) = *(const f32x4*)(ALR + tok0 * 16 + tid * 4);
        __syncthreads();
        float cs[16]; float run = 0.f;
#pragma unroll
        for (int i = 0; i < 16; ++i) { const LAS f32x4* ar = (const LAS f32x4*)(L + oALR + (16 * seg + i) * 64); const f32x4 a0 = ar[0], a1 = ar[1], a2 = ar[2], a3 = ar[3];
            float z = ba + a0.x * w2[0] + a0.y * w2[1] + a0.z * w2[2] + a0.w * w2[3] + a1.x * w2[4] + a1.y * w2[5] + a1.z * w2[6] + a1.w * w2[7]
                         + a2.x * w2[8] + a2.y * w2[9] + a2.z * w2[10] + a2.w * w2[11] + a3.x * w2[12] + a3.y * w2[13] + a3.z * w2[14] + a3.w * w2[15];
            const float la = (fminf(z, 0.f) - __logf(1.0f + fast_exp(-fabsf(z)))) * (1.0f / 16.0f);
            run += la; cs[i] = run; }
        LAS float* SEGp = (LAS float*)(L + oSEG);
        SEGp[seg * 128 + kk] = run;
        __syncthreads();
        float off = 0.f, bl = 0.f;
#pragma unroll
        for (int s = 0; s < 4; ++s) { const float v = SEGp[s * 128 + kk]; bl += v; off += (s < seg) ? v : 0.f; }
        const float eb = fast_exp(bl);
#pragma unroll
        for (int i = 0; i < 16; ++i) { const int t = 16 * seg + i; const float E = fast_exp(off + cs[i]), Ei = fast_rcp(E);
            LAS unsigned short* qp = (LAS unsigned short*)(L + oQT + t * RS) + kk; LAS unsigned short* kp = (LAS unsigned short*)(L + oKT + t * RS) + kk; LAS unsigned short* ep = (LAS unsigned short*)(L + oKE + t * RS) + kk;
            const float qv = bf2f(*qp), kv = bf2f(*kp);
            *qp = f2bf(qv * QSCALE * E); *kp = f2bf(kv * Ei); *ep = f2bf(kv * Ei * eb); }
        if (seg == 0) DEC[(size_t)item * 128 + kk] = eb;
        __syncthreads();
        const int tt = w >> 1;
#pragma unroll
        for (int j = 0; j < 2; ++j) { const int st = 2 * (w & 1) + j; f32x4 acc = {0.f, 0.f, 0.f, 0.f};
#pragma unroll
            for (int ks = 0; ks < 4; ++ks) { const bf16x8 a = *(const LAS bf16x8*)(L + oKT + (16 * st + fr) * RS + (32 * ks + 8 * g) * 2); const bf16x8 bq = *(const LAS bf16x8*)(L + oQT + (16 * tt + fr) * RS + (32 * ks + 8 * g) * 2);
                acc = MFMA16(a, bq, acc); }
            const int t = 16 * tt + fr, s0 = 16 * st + 4 * g;
            u32x2 o; o.x = cvt_pk_bf16(s0 + 0 <= t ? acc[0] : 0.f, s0 + 1 <= t ? acc[1] : 0.f); o.y = cvt_pk_bf16(s0 + 2 <= t ? acc[2] : 0.f, s0 + 3 <= t ? acc[3] : 0.f);
            if (!dry) *(u32x2*)(PB + (size_t)item * 4096 + t * 64 + s0) = o; }
#pragma unroll
        for (int c = tid; c < 1024; c += 512) { const int row = c >> 4, c16 = c & 15; const size_t go = (tok0 + row) * 512 + hd * 128 + c16 * 8;
            const u32x4 q_ = *(const LAS u32x4*)(L + oQT + row * RS + c16 * 16), k_ = *(const LAS u32x4*)(L + oKE + row * RS + c16 * 16); if (!dry) { *(u32x4*)(Q + go) = q_; *(u32x4*)(K + go) = k_; } }
    }
}

DI bf16x8 tr_pair(const LAS unsigned char* p, int rowstride4) {
    const s16x4 lo = __builtin_amdgcn_ds_read_tr16_b64_v4i16((LAS s16x4*)p);
    const s16x4 hi = __builtin_amdgcn_ds_read_tr16_b64_v4i16((LAS s16x4*)(p + rowstride4));
    return __builtin_shufflevector(lo, hi, 0, 1, 2, 3, 4, 5, 6, 7);
}
DI void phase_gla_chain(Frame& F, const Args& A) {
    LAS unsigned char* L = F.lds;
    constexpr int BUF = 53760, oQD = 0, oKE = 17408, oV = 34816, oP = 44032, oDEC = 53248, oST = 2 * BUF, RS = 272, RV = 144;
    const int tid = F.tid, lane = F.lane, w = F.wave, g = lane >> 4, fr = lane & 15, q4 = fr >> 2, p4 = fr & 3;
    const bf16_t* Q = wsp<bf16_t>(F, WS_Q); const bf16_t* K = wsp<bf16_t>(F, WS_K); const bf16_t* V = wsp<bf16_t>(F, WS_V);
    const bf16_t* PB = wsp<bf16_t>(F, WS_PBUF); const float* DEC = wsp<float>(F, WS_DEC);
    bf16_t* GB = wsp<bf16_t>(F, WS_G); float* SSQ = wsp<float>(F, WS_SSQ);
    for (int chain = F.vcu; chain < 256; chain += F.G) {
        const int b = chain >> 4, hd = (chain >> 2) & 3, vs = chain & 3;
        const int item0 = b * 128 + hd * 32; const size_t tokb = (size_t)b * SEQ;
        f32x4 S[4];
#pragma unroll
        for (int i = 0; i < 4; ++i) S[i] = (f32x4){0.f, 0.f, 0.f, 0.f};
        u32x4 pq[2], pk[2], pv, pp; float pd = 0.f;
        const int r16 = tid >> 4, c16 = tid & 15, r8 = tid >> 3, c8 = tid & 7;
#define GC_LOAD(n_) do { const size_t t0_ = tokb + (size_t)(n_) * 64; const int it_ = item0 + (n_); \
            pq[0] = *(const u32x4*)(Q + (t0_ + r16) * 512 + hd * 128 + c16 * 8); pq[1] = *(const u32x4*)(Q + (t0_ + r16 + 32) * 512 + hd * 128 + c16 * 8); \
            pk[0] = *(const u32x4*)(K + (t0_ + r16) * 512 + hd * 128 + c16 * 8); pk[1] = *(const u32x4*)(K + (t0_ + r16 + 32) * 512 + hd * 128 + c16 * 8); \
            pv = *(const u32x4*)(V + (t0_ + r8) * 1024 + hd * 256 + vs * 64 + c8 * 8); pp = *(const u32x4*)(PB + (size_t)it_ * 4096 + r8 * 64 + c8 * 8); \
            if (tid < 128) pd = DEC[(size_t)it_ * 128 + tid]; } while (0)
#define GC_WRITE(bo_) do { *(LAS u32x4*)(L + (bo_) + oQD + r16 * RS + c16 * 16) = pq[0]; *(LAS u32x4*)(L + (bo_) + oQD + (r16 + 32) * RS + c16 * 16) = pq[1]; \
            *(LAS u32x4*)(L + (bo_) + oKE + r16 * RS + c16 * 16) = pk[0]; *(LAS u32x4*)(L + (bo_) + oKE + (r16 + 32) * RS + c16 * 16) = pk[1]; \
            *(LAS u32x4*)(L + (bo_) + oV + r8 * RV + c8 * 16) = pv; *(LAS u32x4*)(L + (bo_) + oP + r8 * RV + c8 * 16) = pp; \
            if (tid < 128) *(LAS float*)(L + (bo_) + oDEC + tid * 4) = pd; } while (0)
        __syncthreads();
        for (int i = tid; i < 64 * RS / 16; i += 512) *(LAS u32x4*)(L + oST + i * 16) = (u32x4){0u, 0u, 0u, 0u};
        GC_LOAD(0); GC_WRITE(0);
        __syncthreads();
        const int tt = w >> 1, trow = 16 * tt + fr;
        f32x4 gnv[2]; u32x2 gq[2], gqn[2];
#pragma unroll
        for (int j = 0; j < 2; ++j) { gnv[j] = *(const f32x4*)(A.in[I_GNORM] + hd * 256 + vs * 64 + 16 * (2 * (w & 1) + j) + 4 * g);
            gqn[j] = *(const u32x2*)(GB + (tokb + trow) * 1024 + hd * 256 + vs * 64 + 16 * (2 * (w & 1) + j) + 4 * g); }
        for (int n = 0; n < 32; ++n) {
            const int cur = (n & 1) * BUF;
            if (n + 1 < 32) GC_LOAD(n + 1);
#pragma unroll
            for (int j = 0; j < 2; ++j) { gq[j] = gqn[j]; if (n + 1 < 32) gqn[j] = *(const u32x2*)(GB + (tokb + (size_t)(n + 1) * 64 + trow) * 1024 + hd * 256 + vs * 64 + 16 * (2 * (w & 1) + j) + 4 * g); }
            bf16x8 pf[2], qf[4];
#pragma unroll
            for (int ks = 0; ks < 2; ++ks) pf[ks] = *(const LAS bf16x8*)(L + cur + oP + trow * RV + (32 * ks + 8 * g) * 2);
#pragma unroll
            for (int ks = 0; ks < 4; ++ks) qf[ks] = *(const LAS bf16x8*)(L + cur + oQD + trow * RS + (32 * ks + 8 * g) * 2);
            float ss = 0.f;
#pragma unroll
            for (int j = 0; j < 2; ++j) { const int vt = 2 * (w & 1) + j; f32x4 o = {0.f, 0.f, 0.f, 0.f};
#pragma unroll
                for (int ks = 0; ks < 2; ++ks) { const bf16x8 vf = tr_pair(L + cur + oV + (32 * ks + 8 * g + q4) * RV + (16 * vt + 4 * p4) * 2, 4 * RV); o = MFMA16(vf, pf[ks], o); }
#pragma unroll
                for (int ks = 0; ks < 4; ++ks) { const bf16x8 sf = *(const LAS bf16x8*)(L + oST + (16 * vt + fr) * RS + (32 * ks + 8 * g) * 2); o = MFMA16(sf, qf[ks], o); }
                ss += o[0] * o[0] + o[1] * o[1] + o[2] * o[2] + o[3] * o[3];
                const float g0 = bf_lo(gq[j].x), g1 = bf_hi(gq[j].x), g2 = bf_lo(gq[j].y), g3 = bf_hi(gq[j].y);
                u32x2 ob; ob.x = cvt_pk_bf16(o[0] * gnv[j][0] * silu_f(g0), o[1] * gnv[j][1] * silu_f(g1)); ob.y = cvt_pk_bf16(o[2] * gnv[j][2] * silu_f(g2), o[3] * gnv[j][3] * silu_f(g3));
                *(u32x2*)(GB + (tokb + (size_t)n * 64 + trow) * 1024 + hd * 256 + vs * 64 + 16 * vt + 4 * g) = ob; }
            ss += __shfl_xor(ss, 16); ss += __shfl_xor(ss, 32);
            if (g == 0) SSQ[((tokb + (size_t)n * 64 + trow) * 4 + hd) * 8 + vs * 2 + (w & 1)] = ss;
            const f32x4 d4 = *(const LAS f32x4*)(L + cur + oDEC + (16 * w + 4 * g) * 4);
#pragma unroll
            for (int vt = 0; vt < 4; ++vt) S[vt] = S[vt] * d4;
#pragma unroll
            for (int ks = 0; ks < 2; ++ks) { const bf16x8 kf = tr_pair(L + cur + oKE + (32 * ks + 8 * g + q4) * RS + (16 * w + 4 * p4) * 2, 4 * RS);
#pragma unroll
                for (int vt = 0; vt < 4; ++vt) { const bf16x8 vf = tr_pair(L + cur + oV + (32 * ks + 8 * g + q4) * RV + (16 * vt + 4 * p4) * 2, 4 * RV); S[vt] = MFMA16(kf, vf, S[vt]); } }
            __syncthreads();
#pragma unroll
            for (int vt = 0; vt < 4; ++vt) { u32x2 sb; sb.x = cvt_pk_bf16(S[vt][0], S[vt][1]); sb.y = cvt_pk_bf16(S[vt][2], S[vt][3]);
                *(LAS u32x2*)(L + oST + (16 * vt + fr) * RS + (16 * w + 4 * g) * 2) = sb; }
            if (n + 1 < 32) GC_WRITE(BUF - cur);
            __syncthreads();
        }
#undef GC_LOAD
#undef GC_WRITE
    }
}

DI void phase_rnn_chain(Frame& F, const Args& A, const bool dry) {
    LAS unsigned char* L = F.lds;
    constexpr int oU = 0, RU = 272, oA = 34816, oB = 68608, RAB = 528, oH = 34816, RH = 272, oSA = 102400, oSB = 104448, oHC = 106496, oCW = 107008, oGW = 109568;
    const int tid = F.tid, lane = F.lane, w = F.wave, g = lane >> 4, fr = lane & 15, wt = w >> 1, wn = w & 1;
    const bf16_t* RX = wsp<bf16_t>(F, WS_RX); bf16_t* RY = wsp<bf16_t>(F, WS_RY); const bf16_t* RGT = wsp<bf16_t>(F, WS_RGT);
    for (int chain = F.vcu; chain < 256; chain += F.G) {
        const int b = chain >> 4, blk = (chain >> 1) & 7, half = chain & 1, C0 = blk * 128, OC0 = C0 + half * 64;
        __syncthreads();
        for (int i = tid; i < 640; i += 512) { const int k = i >> 7, c = i & 127; ((LAS float*)(L + oCW))[i] = (k < 4) ? A.in[I_CONVW][k * 1024 + C0 + c] : A.in[I_CONVB][C0 + c]; }
        if (tid < 128) ((LAS float*)(L + oHC))[tid] = 0.f;
        for (int i = tid; i < 2048; i += 512) { const int row = i >> 4, c16 = i & 15, G2 = row >> 6, ocl = row & 63;
            *(LAS u32x4*)(L + oGW + row * RU + c16 * 16) = *(const u32x4*)(RGT + ((size_t)(blk * 2 + G2) * 128 + half * 64 + ocl) * 128 + c16 * 8); }
        float ba[2], bx[2], c8[2];
#pragma unroll
        for (int nt = 0; nt < 2; ++nt) { const int oc = half * 64 + 32 * wn + 16 * nt + fr;
            ba[nt] = A.in[I_RGBA][C0 + oc]; bx[nt] = A.in[I_RGBX][C0 + oc]; c8[nt] = 8.0f * log1pf(expf(-A.in[I_LAM][C0 + oc])); }
        const int tl = tid >> 4, cg = tid & 15;
        u32x4 xr[7], yr[2];
#define RN_LOADX(t0_) do { _Pragma("unroll") for (int i_ = 0; i_ < 7; ++i_) { const int si_ = (t0_) + 4 * tl - 3 + i_; \
            xr[i_] = (si_ >= 0) ? *(const u32x4*)(RX + ((size_t)b * SEQ + si_) * 1024 + C0 + 8 * cg) : (u32x4){0u, 0u, 0u, 0u}; } } while (0)
        RN_LOADX(0);
        __syncthreads();
        for (int j = 0; j < SEQ / 128; ++j) {
            const int t0 = j * 128;
            { f32x4 cw[5][2];
#pragma unroll
              for (int k = 0; k < 5; ++k) { cw[k][0] = *(const LAS f32x4*)(L + oCW + (k * 128 + 8 * cg) * 4); cw[k][1] = *(const LAS f32x4*)(L + oCW + (k * 128 + 8 * cg + 4) * 4); }
              float xf[7][8];
#pragma unroll
              for (int i = 0; i < 7; ++i) unpack8(xr[i], xf[i]);
#pragma unroll
              for (int i = 0; i < 4; ++i) { float u8[8];
#pragma unroll
                  for (int c = 0; c < 8; ++c) { float u = cw[4][c >> 2][c & 3];
#pragma unroll
                      for (int k = 0; k < 4; ++k) u += cw[k][c >> 2][c & 3] * xf[i + k][c];
                      u8[c] = u; }
                  u32x4 uw; uw.x = cvt_pk_bf16(u8[0], u8[1]); uw.y = cvt_pk_bf16(u8[2], u8[3]); uw.z = cvt_pk_bf16(u8[4], u8[5]); uw.w = cvt_pk_bf16(u8[6], u8[7]);
                  *(LAS u32x4*)(L + oU + (4 * tl + i) * RU + cg * 16) = uw; } }
            __syncthreads();
            if (j + 1 < SEQ / 128) RN_LOADX(t0 + 128);
#pragma unroll
            for (int i = 0; i < 2; ++i) { const int idx = tid + 512 * i, tok = idx >> 3, cgp = idx & 7; yr[i] = *(const u32x4*)(RY + ((size_t)b * SEQ + t0 + tok) * 1024 + OC0 + 8 * cgp); }
            f32x4 aa[2][2], ax[2][2];
#pragma unroll
            for (int mt = 0; mt < 2; ++mt)
#pragma unroll
                for (int nt = 0; nt < 2; ++nt) { aa[mt][nt] = (f32x4){0.f, 0.f, 0.f, 0.f}; ax[mt][nt] = (f32x4){0.f, 0.f, 0.f, 0.f}; }
#pragma unroll
            for (int ks = 0; ks < 4; ++ks)
#pragma unroll
                for (int mt = 0; mt < 2; ++mt) { const bf16x8 af = *(const LAS bf16x8*)(L + oU + (32 * wt + 16 * mt + fr) * RU + (32 * ks + 8 * g) * 2);
#pragma unroll
                    for (int nt = 0; nt < 2; ++nt) { const bf16x8 b0 = *(const LAS bf16x8*)(L + oGW + (32 * wn + 16 * nt + fr) * RU + (32 * ks + 8 * g) * 2), b1 = *(const LAS bf16x8*)(L + oGW + (64 + 32 * wn + 16 * nt + fr) * RU + (32 * ks + 8 * g) * 2);
                        aa[mt][nt] = MFMA16(af, b0, aa[mt][nt]); ax[mt][nt] = MFMA16(af, b1, ax[mt][nt]); } }
#pragma unroll
            for (int mt = 0; mt < 2; ++mt)
#pragma unroll
                for (int nt = 0; nt < 2; ++nt) { const int o = 32 * wn + 16 * nt + fr, tk = 32 * wt + 16 * mt + 4 * g; f32x4 av, bv;
#pragma unroll
                    for (int r = 0; r < 4; ++r) { const float uval = bf2f(*((const LAS unsigned short*)(L + oU + (tk + r) * RU) + half * 64 + o));
                        const float rg = sigmoid_f(aa[mt][nt][r] + ba[nt]), ig = sigmoid_f(ax[mt][nt][r] + bx[nt]);
                        const float a = fast_exp(-c8[nt] * rg); const float mult = __builtin_amdgcn_sqrtf(fmaxf(1.0f - a * a, 0.f));
                        av[r] = a; bv[r] = mult * ig * uval; }
                    *(LAS f32x4*)(L + oA + o * RAB + tk * 4) = av; *(LAS f32x4*)(L + oB + o * RAB + tk * 4) = bv; }
            __syncthreads();
            { const int ch = tid >> 3, sg = tid & 7; float a16[16], h16[16];
#pragma unroll
              for (int q = 0; q < 4; ++q) { const f32x4 av = *(const LAS f32x4*)(L + oA + ch * RAB + (16 * sg + 4 * q) * 4), bv = *(const LAS f32x4*)(L + oB + ch * RAB + (16 * sg + 4 * q) * 4);
#pragma unroll
                  for (int r = 0; r < 4; ++r) { a16[4 * q + r] = av[r]; h16[4 * q + r] = bv[r]; } }
              float ac = 1.f, hl = 0.f;
#pragma unroll
              for (int i = 0; i < 16; ++i) { hl = a16[i] * hl + h16[i]; ac *= a16[i]; h16[i] = hl; a16[i] = ac; }
              ((LAS float*)(L + oSA))[ch * 8 + sg] = ac; ((LAS float*)(L + oSB))[ch * 8 + sg] = hl;
              __syncthreads();
              float carry = ((const LAS float*)(L + oHC))[(j & 1) * 64 + ch];
#pragma unroll
              for (int s = 0; s < 7; ++s) { const float sa = ((const LAS float*)(L + oSA))[ch * 8 + s], sb = ((const LAS float*)(L + oSB))[ch * 8 + s]; carry = (s < sg) ? sa * carry + sb : carry; }
#pragma unroll
              for (int i = 0; i < 16; ++i) { const float h = h16[i] + a16[i] * carry; h16[i] = h; *(LAS float*)(L + oH + (16 * sg + i) * RH + ch * 4) = h; }
              if (sg == 7) ((LAS float*)(L + oHC))[((j + 1) & 1) * 64 + ch] = h16[15]; }
            __syncthreads();
#pragma unroll
            for (int i = 0; i < 2; ++i) { const int idx = tid + 512 * i, tok = idx >> 3, cgp = idx & 7; float yf[8]; unpack8(yr[i], yf);
                const f32x4 h0 = *(const LAS f32x4*)(L + oH + tok * RH + cgp * 32), h1 = *(const LAS f32x4*)(L + oH + tok * RH + cgp * 32 + 16);
                float r[8];
#pragma unroll
                for (int c = 0; c < 4; ++c) { r[c] = h0[c] * gelu_tanh_f(yf[c]); r[4 + c] = h1[c] * gelu_tanh_f(yf[4 + c]); }
                u32x4 wv; wv.x = cvt_pk_bf16(r[0], r[1]); wv.y = cvt_pk_bf16(r[2], r[3]); wv.z = cvt_pk_bf16(r[4], r[5]); wv.w = cvt_pk_bf16(r[6], r[7]);
                if (!dry) *(u32x4*)(RY + ((size_t)b * SEQ + t0 + tok) * 1024 + OC0 + 8 * cgp) = wv; }
        }
#undef RN_LOADX
    }
}

DI void phase_ln1_router(Frame& F, const Args& A, const bf16_t* zsrc, const bool dry) {
    LAS unsigned char* L = F.lds;
    constexpr int RW = 1028;
    LAS float* WRE = (LAS float*)L;
    LAS float* WRG = (LAS float*)(L + 32 * RW * 4);
    LAS int* HIST = (LAS int*)(L + LDSCTL_OFF + 64);
    const int tid = F.tid, lane = F.lane, w = F.wave;
    bf16_t* X1B = wsp<bf16_t>(F, WS_X1B); int* TOKE = wsp<int>(F, WS_TOKE); float* TOKW = wsp<float>(F, WS_TOKW);
    __syncthreads();
    for (int i = tid; i < 32 * 1024; i += 512) { const int k = i >> 5, e = i & 31; WRE[e * RW + k] = A.in[I_RWE][i]; }
    for (int i = tid; i < 4 * 1024; i += 512) { const int k = i >> 2, e = i & 3; WRG[e * RW + k] = A.in[I_RWG][i]; }
    if (tid < 32) HIST[tid] = 0;
    __syncthreads();
    f32x4 g1[4], b1[4];
#pragma unroll
    for (int j = 0; j < 4; ++j) { g1[j] = *((const f32x4*)A.in[I_LN1G] + lane + 64 * j); b1[j] = *((const f32x4*)A.in[I_LN1B] + lane + 64 * j); }
    const int TPW = NTOK / F.G;
    for (int it = 0; it < TPW / 16; ++it) {
        const int m = F.vcu * TPW + it * 16 + w * 2;
        f32x4 xv[2][4];
#pragma unroll
        for (int r = 0; r < 2; ++r) { float s = 0.f;
#pragma unroll
            for (int j = 0; j < 4; ++j) { const u32x2 zw = *(const u32x2*)(zsrc + (size_t)(m + r) * D + 4 * lane + 256 * j); xv[r][j] = (f32x4){bf_lo(zw.x), bf_hi(zw.x), bf_lo(zw.y), bf_hi(zw.y)}; s += (xv[r][j].x + xv[r][j].y) + (xv[r][j].z + xv[r][j].w); }
            const float mean = wave_sum(s) * (1.f / D); float s2 = 0.f;
#pragma unroll
            for (int j = 0; j < 4; ++j) { xv[r][j] = xv[r][j] - mean; s2 += (xv[r][j].x * xv[r][j].x + xv[r][j].y * xv[r][j].y) + (xv[r][j].z * xv[r][j].z + xv[r][j].w * xv[r][j].w); }
            const float rstd = __builtin_amdgcn_rsqf(wave_sum(s2) * (1.f / D) + LN_EPS);
#pragma unroll
            for (int j = 0; j < 4; ++j) { xv[r][j] = xv[r][j] * rstd * g1[j] + b1[j];
                u32x2 wv; wv.x = cvt_pk_bf16(xv[r][j].x, xv[r][j].y); wv.y = cvt_pk_bf16(xv[r][j].z, xv[r][j].w);
                if (!dry) *(u32x2*)(X1B + (size_t)(m + r) * D + 4 * lane + 256 * j) = wv; } }
        float gl[2][4];
#pragma unroll
        for (int e = 0; e < 4; ++e) { float s0 = 0.f, s1 = 0.f;
#pragma unroll
            for (int j = 0; j < 4; ++j) { const f32x4 wv = *(const LAS f32x4*)(WRG + e * RW + 256 * j + 4 * lane);
                s0 += xv[0][j].x * wv.x + xv[0][j].y * wv.y + xv[0][j].z * wv.z + xv[0][j].w * wv.w; s1 += xv[1][j].x * wv.x + xv[1][j].y * wv.y + xv[1][j].z * wv.z + xv[1][j].w * wv.w; }
            gl[0][e] = wave_sum(s0) + A.in[I_RBG][e]; gl[1][e] = wave_sum(s1) + A.in[I_RBG][e]; }
#pragma unroll
        for (int r = 0; r < 2; ++r) {
            int grp = 0; float gmax = gl[r][0];
#pragma unroll
            for (int e = 1; e < 4; ++e) if (gl[r][e] > gmax) { gmax = gl[r][e]; grp = e; }
            grp = __builtin_amdgcn_readfirstlane(grp);
            float gs = 0.f;
#pragma unroll
            for (int e = 0; e < 4; ++e) gs += __expf(gl[r][e] - gmax);
            const float pg = 1.0f / gs;
            float el[8];
#pragma unroll
            for (int e = 0; e < 8; ++e) { float s = 0.f;
#pragma unroll
                for (int j = 0; j < 4; ++j) { const f32x4 wv = *(const LAS f32x4*)(WRE + (grp * 8 + e) * RW + 256 * j + 4 * lane);
                    s += xv[r][j].x * wv.x + xv[r][j].y * wv.y + xv[r][j].z * wv.z + xv[r][j].w * wv.w; }
                el[e] = wave_sum(s) + A.in[I_RBE][grp * 8 + e]; }
            int i0 = 0; float m0 = el[0];
#pragma unroll
            for (int e = 1; e < 8; ++e) if (el[e] > m0) { m0 = el[e]; i0 = e; }
            int i1 = -1; float m1 = -3.0e38f;
#pragma unroll
            for (int e = 0; e < 8; ++e) if (e != i0 && el[e] > m1) { m1 = el[e]; i1 = e; }
            const float p1 = __expf(m1 - m0), inv = 1.0f / (1.0f + p1);
            if (lane == 0 && !dry) { const int e0 = grp * 8 + i0, e1 = grp * 8 + i1;
                TOKE[(size_t)(m + r) * 2] = e0; TOKE[(size_t)(m + r) * 2 + 1] = e1; TOKW[(size_t)(m + r) * 2] = pg * inv; TOKW[(size_t)(m + r) * 2 + 1] = pg * p1 * inv;
                atomicAdd((int*)(HIST + e0), 1); atomicAdd((int*)(HIST + e1), 1); }
        }
    }
    __syncthreads();
    if (tid < 32 && !dry) ((int*)F.ctl)[CW_WGCNT + F.vcu * 32 + tid] = HIST[tid];
}

DI void phase_dispatch(Frame& F, const Args& A) {
    LAS int* TOT = (LAS int*)(F.lds + LDSCTL_OFF + 256); LAS int* PB = TOT + 32; LAS int* POFF = TOT + 64; LAS int* CUR = TOT + 96;
    const int tid = F.tid; const int* WGC = (const int*)F.ctl + CW_WGCNT; const int* TOKE = wsp<int>(F, WS_TOKE); const float* TOKW = wsp<float>(F, WS_TOKW);
    int* row_tok = wsp<int>(F, WS_ROWS); float* row_w = (float*)(row_tok + MAXROWS); int* row_slot = row_tok + 2 * MAXROWS;
    __syncthreads();
    if (tid < 32) { int tot = 0, before = 0; for (int g = 0; g < F.G; ++g) { const int c = WGC[g * 32 + tid]; tot += c; before += (g < F.vcu) ? c : 0; } TOT[tid] = tot; PB[tid] = before; CUR[tid] = 0; }
    __syncthreads();
    if (tid == 0) { int po = 0; for (int e = 0; e < 32; ++e) { POFF[e] = po; if (F.vcu == 0) ((int*)F.ctl)[CW_TS + e] = po >> 8; po += (TOT[e] + 255) & ~255; } if (F.vcu == 0) ((int*)F.ctl)[CW_TS + 32] = po >> 8; }
    __syncthreads();
    const int TPW = NTOK / F.G;
    for (int a = tid; a < 2 * TPW; a += 512) { const int t = F.vcu * TPW + (a >> 1), k = a & 1; const int e = TOKE[(size_t)t * 2 + k];
        const int pos = POFF[e] + PB[e] + atomicAdd((int*)(CUR + e), 1);
        row_tok[pos] = t; row_w[pos] = TOKW[(size_t)t * 2 + k]; row_slot[pos] = 2 * t + k; }
    for (int e = F.vcu; e < 32; e += F.G) { const int lo = POFF[e] + TOT[e], hi = POFF[e] + ((TOT[e] + 255) & ~255);
        for (int r = lo + tid; r < hi; r += 512) { row_tok[r] = 0; row_w[r] = 0.f; row_slot[r] = -1; } }
}

DI void phase_final(Frame& F, const Args& A, int use_moe, const bool dry) {
    const int lane = F.lane; const int gw = F.vcu * NWAVES + F.wave, NGW = F.G * NWAVES;
    float* X1 = F.out; const bf16_t* SL = wsp<bf16_t>(F, WS_SLOTS); const bf16_t* X1B = wsp<bf16_t>(F, WS_X1B);
    f32x4 g2[4], b2[4];
#pragma unroll
    for (int j = 0; j < 4; ++j) { g2[j] = *((const f32x4*)A.in[I_LN2G] + lane + 64 * j); b2[j] = *((const f32x4*)A.in[I_LN2B] + lane + 64 * j); }
    for (int m = gw; m < NTOK; m += NGW) {
        f32x4 v[4]; float s = 0.f;
#pragma unroll
        for (int j = 0; j < 4; ++j) { { const u32x2 xw = *(const u32x2*)(X1B + (size_t)m * D + 4 * lane + 256 * j); v[j] = (f32x4){bf_lo(xw.x), bf_hi(xw.x), bf_lo(xw.y), bf_hi(xw.y)} * DN_ALPHA; }
            if (use_moe) { const u32x2 a = *(const u32x2*)(SL + (size_t)(2 * m) * D + 4 * lane + 256 * j), c = *(const u32x2*)(SL + (size_t)(2 * m + 1) * D + 4 * lane + 256 * j);
                v[j].x += bf_lo(a.x) + bf_lo(c.x); v[j].y += bf_hi(a.x) + bf_hi(c.x); v[j].z += bf_lo(a.y) + bf_lo(c.y); v[j].w += bf_hi(a.y) + bf_hi(c.y); }
            s += (v[j].x + v[j].y) + (v[j].z + v[j].w); }
        const float mean = wave_sum(s) * (1.f / D); float s2 = 0.f;
#pragma unroll
        for (int j = 0; j < 4; ++j) { v[j] = v[j] - mean; s2 += (v[j].x * v[j].x + v[j].y * v[j].y) + (v[j].z * v[j].z + v[j].w * v[j].w); }
        const float rstd = __builtin_amdgcn_rsqf(wave_sum(s2) * (1.f / D) + LN_EPS);
#pragma unroll
        for (int j = 0; j < 4; ++j) { const f32x4 o_ = v[j] * rstd * g2[j] + b2[j]; if (!dry) *((f32x4*)(X1 + (size_t)m * D) + lane + 64 * j) = o_; }
    }
}

constexpr int N_PHASES = 11;
__global__ void __launch_bounds__(NWAVES * 64, 2) fwd(Args args) {
    extern __shared__ __attribute__((aligned(16))) unsigned char lds[];
    Frame F;
    F.lds = (LAS unsigned char*)lds;
    F.tid = threadIdx.x; F.lane = F.tid & 63; F.wave = __builtin_amdgcn_readfirstlane(F.tid >> 6);
    F.G = gridDim.x; { const int bx = blockIdx.x; F.vcu = (F.G % 8 == 0) ? (bx % 8) * (F.G / 8) + bx / 8 : bx; }
    F.ws = args.ws; F.ctl = (unsigned*)(args.ws + WS_CTL); F.out = args.out;
    for (int u = F.tid; u < (LDS_BYTES - LDSCTL_OFF) / 4; u += NWAVES * 64) ((LAS unsigned*)(F.lds + LDSCTL_OFF))[u] = 0u;
    __syncthreads();
    const int lo = args.ph_lo, hi = args.ph_hi;
    XcdBarrier bar; bar.bar = F.ctl + CW_BAR; bar.x = 0; bar.st = nullptr;
    if (hi - lo > 1) bar = xcd_barrier_post(F.ctl + CW_BAR, (volatile LAS unsigned*)(F.lds + LDSCTL_OFF));
#define IN(k) (lo <= (k) && (k) < hi)
#define SEAM(k) do { if (IN(k) && IN((k) + 1)) xcd_barrier(bar); } while (0)
    LAS unsigned char* ring = F.lds;
    constexpr int ST = MK_STAGE;
#define DUP(k) ((MK_DUP >> (k)) & 1)
    if (IN(0)) { if (DUP(0)) p0_prologue(F, args); p0_prologue(F, args); } SEAM(0);
    if (IN(1)) {
#pragma unroll
        for (int rep = 0; rep < 1 + DUP(1); ++rep) {
        pg8::StaticOrder S; S.init(wsp<bf16_t>(F, WS_XB), wsp<bf16_t>(F, WS_WIN), NTOK, NPROJ, D, F.G, (int)blockIdx.x);
        EpiProj E{wsp<bf16_t>(F, WS_RX), wsp<bf16_t>(F, WS_RY), wsp<bf16_t>(F, WS_Q), wsp<bf16_t>(F, WS_K), wsp<bf16_t>(F, WS_V), wsp<bf16_t>(F, WS_G), (bf16_t*)F.out, (bf16_t*)F.out + (size_t)NTOK * D, args.in[I_BIN]};
        pg8::gemm_phase<EpiProj, pg8::StaticOrder, pg8::NoHook, false, true, true>(ring, D, S, E, pg8::NoHook{}); } } SEAM(1);
    if (IN(2)) { if (DUP(2)) { phase_gla_pre(F, args, args.dup != 0); phase_rnn_chain(F, args, args.dup != 0); } phase_gla_pre(F, args, false); phase_rnn_chain(F, args, false); } SEAM(2);
    if (IN(3)) { phase_gla_chain(F, args); } SEAM(3);
    if (IN(4)) {
        LAS float* rstab = (LAS float*)(F.lds + AUX_OFF);
        { pg8::StaticOrder S0; S0.init(wsp<bf16_t>(F, WS_RY), wsp<bf16_t>(F, WS_WR), NTOK, D, D, F.G, (int)blockIdx.x);
          pg8::Unit u; const int ui = F.tid >> 8, r = F.tid & 255;
          __syncthreads();
          if (S0.next(ui, u)) { const float* sq = wsp<float>(F, WS_SSQ) + ((size_t)(u.pm * 256 + r) * 4) * 8; f32x4 o;
#pragma unroll
              for (int h = 0; h < 4; ++h) { const f32x4 s0 = *(const f32x4*)(sq + h * 8), s1 = *(const f32x4*)(sq + h * 8 + 4); o[h] = __builtin_amdgcn_rsqf(((s0.x + s0.y) + (s0.z + s0.w) + (s1.x + s1.y) + (s1.z + s1.w)) * (1.0f / 256.0f) + RMS_EPS); }
              *(LAS f32x4*)(rstab + (ui * 256 + r) * 4) = o; }
          __syncthreads(); }
        { pg8::StaticOrder S; S.init(wsp<bf16_t>(F, WS_RY), wsp<bf16_t>(F, WS_WR), NTOK, D, D, F.G, (int)blockIdx.x);
          EpiMergeA E{(const bf16_t*)F.out, wsp<bf16_t>(F, WS_TMP)};
          pg8::gemm_phase<EpiMergeA, pg8::StaticOrder, pg8::NoHook, false, true, true>(ring, D, S, E, pg8::NoHook{}); }
        { pg8::StaticOrder S; S.init(wsp<bf16_t>(F, WS_G), wsp<bf16_t>(F, WS_WG), NTOK, D, D, F.G, (int)blockIdx.x);
          RowHook H{rstab};
          EpiMergeB E{(const bf16_t*)F.out + (size_t)NTOK * D, wsp<bf16_t>(F, WS_TMP), wsp<bf16_t>(F, WS_MERGED), rstab};
          pg8::gemm_phase<EpiMergeB, pg8::StaticOrder, RowHook, false, true, true>(ring, D, S, E, H); } } SEAM(4);
    if (IN(5)) {
#pragma unroll
        for (int rep = 0; rep < 1 + DUP(5); ++rep) {
        pg8::StaticOrder S; S.init(wsp<bf16_t>(F, WS_MERGED), wsp<bf16_t>(F, WS_WO), NTOK, D, D, F.G, (int)blockIdx.x);
        EpiWo E{wsp<bf16_t>(F, WS_XB), args.in[I_BO], wsp<bf16_t>(F, WS_Z1)};
        pg8::gemm_phase<EpiWo, pg8::StaticOrder, pg8::NoHook, false, true, true>(ring, D, S, E, pg8::NoHook{}); } } SEAM(5);
    if (IN(6)) { if (DUP(6)) phase_ln1_router(F, args, wsp<bf16_t>(F, WS_Z1), args.dup != 0); phase_ln1_router(F, args, wsp<bf16_t>(F, WS_Z1), false); } SEAM(6);
    if (IN(7)) { if (DUP(7)) phase_dispatch(F, args); phase_dispatch(F, args); } SEAM(7);
    if (IN(8)) {
#pragma unroll
        for (int rep = 0; rep < 1 + DUP(8); ++rep) {
        LAS int* ts = (LAS int*)(F.lds + LDSCTL_OFF + 768);
        __syncthreads(); if (F.tid < 33) ts[F.tid] = ((const int*)F.ctl)[CW_TS + F.tid]; __syncthreads();
        MoeOrder S{(const char*)wsp<bf16_t>(F, WS_X1B), (const char*)wsp<bf16_t>(F, WS_E13), D, (size_t)1024 * 1024 * 2, ts, wsp<int>(F, WS_ROWS), F.G, (int)blockIdx.x, 1};
        EpiExp1 E{wsp<bf16_t>(F, WS_H)};
        pg8::gemm_phase<EpiExp1, MoeOrder, pg8::NoHook, true, true, true>(ring, D, S, E, pg8::NoHook{}); } } SEAM(8);
    if (IN(9)) {
#pragma unroll
        for (int rep = 0; rep < 1 + DUP(9); ++rep) {
        LAS int* ts = (LAS int*)(F.lds + LDSCTL_OFF + 768);
        __syncthreads(); if (F.tid < 33) ts[F.tid] = ((const int*)F.ctl)[CW_TS + F.tid]; __syncthreads();
        MoeOrder S{(const char*)wsp<bf16_t>(F, WS_H), (const char*)wsp<bf16_t>(F, WS_E2), FF, (size_t)1024 * 512 * 2, ts, wsp<int>(F, WS_ROWS), F.G, (int)blockIdx.x, 0};
        EpiExp2 E{wsp<int>(F, WS_ROWS) + 2 * MAXROWS, (const float*)(wsp<int>(F, WS_ROWS) + MAXROWS), wsp<bf16_t>(F, WS_SLOTS)};
        pg8::gemm_phase<EpiExp2, MoeOrder, pg8::NoHook, false, true, true>(ring, FF, S, E, pg8::NoHook{}); } } SEAM(9);
    if (IN(10)) { if (DUP(10)) phase_final(F, args, 1, args.dup != 0); phase_final(F, args, 1, false); }
#undef IN
#undef SEAM
}

extern "C" void kernel_launch(void* const* d_in, const int* in_sizes, int n_in, void* d_out, int out_size, void* d_ws, size_t ws_size, hipStream_t stream) {
    static int grid = 0;
    if (grid == 0) {
        if (n_in != 28 || in_sizes[0] != NTOK * D || out_size != NTOK * D || ws_size < WS_END) { fprintf(stderr, "kernel_launch: unexpected shapes (n_in %d, in0 %d, out %d, ws %zu); nothing launched\n", n_in, n_in > 0 ? in_sizes[0] : -1, out_size, ws_size); grid = -1; return; }
        int dev = 0, cus = 0, per_cu = 0;
        if (hipGetDevice(&dev) != hipSuccess || hipDeviceGetAttribute(&cus, hipDeviceAttributeMultiprocessorCount, dev) != hipSuccess) { grid = -1; return; }
        if (hipFuncSetAttribute((const void*)fwd, hipFuncAttributeMaxDynamicSharedMemorySize, LDS_BYTES) != hipSuccess) { fprintf(stderr, "kernel_launch: hipFuncSetAttribute failed\n"); grid = -1; return; }
        if (hipOccupancyMaxActiveBlocksPerMultiprocessor(&per_cu, (const void*)fwd, NWAVES * 64, LDS_BYTES) != hipSuccess || per_cu < 1) { fprintf(stderr, "kernel_launch: occupancy query reports %d workgroups per CU\n", per_cu); }
        (void)hipGetLastError();
        grid = cus;
        if (grid != 256) { fprintf(stderr, "kernel_launch: built for 256 CUs, found %d; nothing launched\n", cus); grid = -1; return; }
    }
    if (grid < 0) return;
    if (hipMemsetAsync((char*)d_ws + WS_CTL, 0, CTL_ZERO_BYTES, stream) != hipSuccess) return;
    Args a{};
    for (int i = 0; i < 28; ++i) a.in[i] = (const float*)d_in[i];
    a.out = (float*)d_out; a.ws = (unsigned char*)d_ws; a.dup = MK_DUP; a.pad = 0;
#if MK_ONE_LAUNCH
    a.ph_lo = 0; a.ph_hi = N_PHASES;
    hipLaunchKernelGGL(fwd, dim3(grid), dim3(NWAVES * 64), LDS_BYTES, stream, a);
#else
    for (int p = 0; p < N_PHASES; ++p) { a.ph_lo = p; a.ph_hi = p + 1; hipLaunchKernelGGL(fwd, dim3(grid), dim3(NWAVES * 64), LDS_BYTES, stream, a); }
#endif
}
```

```cpp
#include <hip/hip_runtime.h>
#include <cstdio>
#include <cstdint>

#ifndef MK_ONE_LAUNCH
#define MK_ONE_LAUNCH 1
#endif
#ifndef MK_DIAG
#define MK_DIAG -1
#endif
#ifndef MK_DUP
#define MK_DUP 0
#endif
#ifndef MK_STAGE
#define MK_STAGE 9
#endif

#define GAS __attribute__((address_space(1)))
#define LAS __attribute__((address_space(3)))
typedef unsigned short bf16_t;
typedef short bf16x8 __attribute__((ext_vector_type(8)));
typedef short s16x4 __attribute__((ext_vector_type(4)));
typedef float f32x4 __attribute__((ext_vector_type(4)));
typedef float f32x2 __attribute__((ext_vector_type(2)));
typedef unsigned u32x4 __attribute__((ext_vector_type(4)));
typedef unsigned u32x2 __attribute__((ext_vector_type(2)));
#define DI __device__ __forceinline__

typedef __bf16 bf16x2_t __attribute__((ext_vector_type(2)));
DI unsigned cvt_pk_bf16(float lo, float hi) { const f32x2 f = {lo, hi}; return __builtin_bit_cast(unsigned, __builtin_convertvector(f, bf16x2_t)); }
DI float bf_lo(unsigned u) { return __uint_as_float(u << 16); }
DI float bf_hi(unsigned u) { return __uint_as_float(u & 0xffff0000u); }
DI float bf2f(unsigned short b) { return __uint_as_float(((unsigned)b) << 16); }
DI unsigned short f2bf(float f) { return (unsigned short)(cvt_pk_bf16(f, 0.f) & 0xffffu); }
DI float fast_exp(float x) { return __builtin_amdgcn_exp2f(x * 1.4426950408889634f); }
DI float fast_rcp(float x) { return __builtin_amdgcn_rcpf(x); }
DI float sigmoid_f(float x) { return fast_rcp(1.0f + fast_exp(-x)); }
DI float silu_f(float x) { return x * sigmoid_f(x); }
DI float gelu_tanh_f(float x) {
    const float u = 1.5957691216057308f * (x + 0.044715f * x * x * x);
    return x * sigmoid_f(u);
}
#define LDS_WAIT() asm volatile("s_waitcnt lgkmcnt(0)" ::: "memory")
#define VM_WAIT() asm volatile("s_waitcnt vmcnt(0)" ::: "memory")
#define LDS_BARRIER() do { asm volatile("s_waitcnt lgkmcnt(0)" ::: "memory"); __builtin_amdgcn_s_barrier(); asm volatile("" ::: "memory"); } while (0)
#define MFMA16(a, b, c) __builtin_amdgcn_mfma_f32_16x16x32_bf16((a), (b), (c), 0, 0, 0)

namespace pg8 {
#define PG8_LAS __attribute__((address_space(3)))
constexpr int BM = 256, BK = 64, HALF = 128, HTB = HALF * BK * 2  , STAGE_BYTES = 8 * HTB, NXCD = 8, WGM = 8;
__host__ __device__ __forceinline__ int lds_byte(int r, int c) { const int st = (r >> 4) * 2 + (c >> 5), rr = r & 15, cc = c & 31, ob = rr * 64 + cc * 2; return st * 1024 + (ob ^ (((ob >> 9) & 1) << 5)); }
__host__ __device__ __forceinline__ void stage_rc(int b, int& R, int& C) { const int st = b / 1024, sb = b % 1024, swz = sb ^ (((sb >> 9) & 1) << 5); R = (st >> 1) * 16 + swz / 64; C = (st & 1) * 32 + (swz % 64) / 2; }
__host__ __device__ __forceinline__ int perm32(int rho) { const int n = rho >> 4, i = rho & 15; return 8 * (i >> 2) + 4 * n + (i & 3); }

struct Unit { int pm, pn, e; };

struct StaticOrder {
    const char* A; const char* Bt; int K; int nM, nN, nwg, G, c;
    __device__ void init(const void* A_, const void* Bt_, int M, int N, int K_, int G_, int c_) { A = (const char*)A_; Bt = (const char*)Bt_; K = K_; nM = M / BM; nN = N / BM; nwg = nM * nN; G = G_; c = c_; }
    __device__ __forceinline__ bool next(int i, Unit& u) const {
        const long L = (long)i * G + c; if (L >= nwg) return false;
        int wgid = (int)L; { const int q = nwg / NXCD, r = nwg % NXCD, xcd = wgid % NXCD, off = wgid / NXCD; wgid = (xcd < r ? xcd * (q + 1) : r * (q + 1) + (xcd - r) * q) + off; }
        const int nig = WGM * nN, gid = wgid / nig, fm = gid * WGM, gsz = (nM - fm) < WGM ? (nM - fm) : WGM;
        u.pm = fm + ((wgid % nig) % gsz); u.pn = (wgid % nig) / gsz; u.e = i; return true;
    }
    __device__ __forceinline__ const char* a_ptr(const Unit& u) const { return A + (size_t)u.pm * BM * K * 2; }
    __device__ __forceinline__ const char* b_ptr(const Unit& u) const { return Bt + (size_t)u.pn * BM * K * 2; }
    __device__ __forceinline__ void a_rows(const Unit&, const int (&)[2], const int (&)[2], unsigned (&)[2][2]) const {}
};
struct NoHook { static constexpr bool ACTIVE = false; __device__ __forceinline__ bool wants(int) const { return false; }
    __device__ __forceinline__ void apply(int, f32x4 (&)[2][2][4][2], const Unit&, int, int, int, int) const {} };

template <class Epi, class Sched, class Hook, bool GATHER, bool ALIGN_EPI, bool SP2>
__device__ __forceinline__ void gemm_phase(PG8_LAS unsigned char* lds, const int K, const Sched& S, const Epi& E, const Hook& H) {
    const int tid = threadIdx.x, wid = __builtin_amdgcn_readfirstlane(tid >> 6), lane = tid & 63, wr = wid >> 2, wc = wid & 3, fr = lane & 15, fq = lane >> 4;
    const int nt = K / BK, lda = K;
    unsigned voffA[2], voffB[2]; int RA[2], CA[2];
#pragma unroll
    for (int i = 0; i < 2; ++i) { int R, C; stage_rc(tid * 16 + i * 8192, R, C); const int Rb = Epi::PERM ? ((R & ~31) + perm32(R & 31)) : R;
        RA[i] = R; CA[i] = C * 2; voffA[i] = (unsigned)(R * lda + C) * 2u; voffB[i] = (unsigned)(Rb * K + C) * 2u; }
    const size_t kstep = (size_t)(BK * 2);
    const size_t hstep = (size_t)HALF * K * 2, hstepA = (size_t)HALF * lda * 2;
    const unsigned ldsw = (unsigned)wid * 1024u;
    const int aoff = lds_byte(wr * 64 + fr, fq * 8), boff = lds_byte(wc * 32 + fr, fq * 8);
#define PG8_SA(b, h) (((b) * 2 + (h)) * HTB)
#define PG8_SB(b, h) ((4 + (b) * 2 + (h)) * HTB)
#define PG8_STAGE2(bufoff, gbase, v0, v1) do { \
        __builtin_amdgcn_global_load_lds((const unsigned*)((const char*)(gbase) + (v0)), (PG8_LAS unsigned*)(lds + (bufoff) + ldsw), 16, 0, 0); \
        __builtin_amdgcn_global_load_lds((const unsigned*)((const char*)(gbase) + (v1)), (PG8_LAS unsigned*)(lds + (bufoff) + ldsw + 8192), 16, 0, 0); } while (0)
#define PG8_STAGE(bufoff, gbase, voff) PG8_STAGE2(bufoff, gbase, (voff)[0], (voff)[1])
#define PG8_STAGE_A(bufoff, abase, h, NXT) do { if constexpr (GATHER) { PG8_STAGE2(bufoff, abase, (NXT) ? gN[h][0] : gC[h][0], (NXT) ? gN[h][1] : gC[h][1]); } else { PG8_STAGE(bufoff, (abase) + (h) * hstepA, voffA); } } while (0)
#define PG8_LDA(dst, b, h) do { _Pragma("unroll") for (int m = 0; m < 4; ++m) _Pragma("unroll") for (int k = 0; k < 2; ++k) dst[m][k] = *(const PG8_LAS bf16x8*)(lds + PG8_SA(b, h) + aoff + m * 2048 + k * 1024); } while (0)
#define PG8_LDB(dst, b, h) do { _Pragma("unroll") for (int n = 0; n < 2; ++n) _Pragma("unroll") for (int k = 0; k < 2; ++k) dst[n][k] = *(const PG8_LAS bf16x8*)(lds + PG8_SB(b, h) + boff + n * 2048 + k * 1024); } while (0)
#define PG8_MMA(ai, bj, At, Bt) do { __builtin_amdgcn_s_setprio(1); _Pragma("unroll") for (int m = 0; m < 4; ++m) _Pragma("unroll") for (int n = 0; n < 2; ++n) _Pragma("unroll") for (int k = 0; k < 2; ++k) \
        acc[ai][bj][m][n] = __builtin_amdgcn_mfma_f32_16x16x32_bf16(Bt[n][k], At[m][k], acc[ai][bj][m][n], 0, 0, 0); __builtin_amdgcn_s_setprio(0); } while (0)
#define PG8_WAIT_V(n) asm volatile("s_waitcnt vmcnt(" #n ")" ::: "memory")
#define PG8_WAIT_L(n) asm volatile("s_waitcnt lgkmcnt(" #n ")" ::: "memory")
#define PG8_BAR __builtin_amdgcn_s_barrier()
#define PG8_SCHED __builtin_amdgcn_sched_barrier(0)
    Unit cur, nxt; int ui = 0;
    if (!S.next(0, cur)) return;
    f32x4 acc[2][2][4][2];
#pragma unroll
    for (int a = 0; a < 2; ++a)
#pragma unroll
        for (int b = 0; b < 2; ++b)
#pragma unroll
            for (int m = 0; m < 4; ++m)
#pragma unroll
                for (int n = 0; n < 2; ++n) acc[a][b][m][n] = (f32x4){0.f, 0.f, 0.f, 0.f};
    bf16x8 At[4][2], B0[2][2], B1[2][2];
    unsigned gC[2][2] = {{0u, 0u}, {0u, 0u}}, gN[2][2] = {{0u, 0u}, {0u, 0u}};
    const char* cA = S.a_ptr(cur); const char* cB = S.b_ptr(cur);
    if constexpr (GATHER) S.a_rows(cur, RA, CA, gC);
    if constexpr (SP2) {
        PG8_STAGE(PG8_SB(0, 0), cB, voffB); PG8_STAGE(PG8_SB(0, 1), cB + hstep, voffB); PG8_STAGE_A(PG8_SA(0, 0), cA, 0, false); PG8_STAGE_A(PG8_SA(0, 1), cA, 1, false);
        if (wr == 1) PG8_BAR;
        PG8_WAIT_V(2); PG8_BAR;
        PG8_STAGE(PG8_SB(1, 0), cB + kstep, voffB); PG8_STAGE_A(PG8_SA(1, 0), cA + kstep, 0, false); PG8_STAGE(PG8_SB(1, 1), cB + hstep + kstep, voffB);
        PG8_WAIT_V(6); PG8_BAR;
    } else {
        PG8_STAGE(PG8_SB(0, 0), cB, voffB); PG8_STAGE_A(PG8_SA(0, 0), cA, 0, false); PG8_STAGE(PG8_SB(0, 1), cB + hstep, voffB); PG8_STAGE_A(PG8_SA(0, 1), cA, 1, false);
        if (wr == 1) PG8_BAR;
        PG8_WAIT_V(4); PG8_BAR;
        PG8_STAGE(PG8_SB(1, 0), cB + kstep, voffB); PG8_STAGE_A(PG8_SA(1, 0), cA + kstep, 0, false); PG8_STAGE(PG8_SB(1, 1), cB + hstep + kstep, voffB);
        PG8_WAIT_V(6); PG8_BAR;
    }
    for (;;) {
        const bool has_next = S.next(ui + 1, nxt);
        const char* nA = has_next ? S.a_ptr(nxt) : cA; const char* nB = has_next ? S.b_ptr(nxt) : cB;
        if constexpr (GATHER) { if (has_next) S.a_rows(nxt, RA, CA, gN); else {
#pragma unroll
            for (int h = 0; h < 2; ++h) { gN[h][0] = gC[h][0]; gN[h][1] = gC[h][1]; } } }
        for (int t = 0; t < nt; t += 2) {
            const bool last = (t == nt - 2);
            const char* a1 = cA + (size_t)(t + 1) * kstep;
            const char* a2 = last ? nA : cA + (size_t)(t + 2) * kstep; const char* b2 = last ? nB : cB + (size_t)(t + 2) * kstep;
            const char* a3 = a2 + kstep; const char* b3 = b2 + kstep;
            if constexpr (Hook::ACTIVE) { if (H.wants(t)) H.apply(t, acc, cur, wr, wc, fr, fq); }
            if constexpr (SP2) {
            PG8_LDB(B0, 0, 0); PG8_LDB(B1, 0, 1); PG8_SCHED; PG8_LDA(At, 0, 0); PG8_STAGE_A(PG8_SA(1, 1), a1, 1, false);
            PG8_WAIT_V(8); PG8_WAIT_L(0); PG8_BAR; PG8_MMA(0, 0, At, B0); PG8_MMA(0, 1, At, B1); PG8_BAR; PG8_SCHED;
            PG8_LDA(At, 0, 1); PG8_STAGE(PG8_SB(0, 0), b2, voffB); PG8_STAGE(PG8_SB(0, 1), b2 + hstep, voffB); PG8_STAGE_A(PG8_SA(0, 0), a2, 0, last);
            PG8_WAIT_V(8); PG8_WAIT_L(0); PG8_BAR; PG8_MMA(1, 0, At, B0); PG8_MMA(1, 1, At, B1); PG8_BAR; PG8_SCHED;
            PG8_LDB(B0, 1, 0); PG8_LDB(B1, 1, 1); PG8_SCHED; PG8_LDA(At, 1, 0); PG8_STAGE_A(PG8_SA(0, 1), a2, 1, last);
            PG8_WAIT_V(8); PG8_WAIT_L(0); PG8_BAR; PG8_MMA(0, 0, At, B0); PG8_MMA(0, 1, At, B1); PG8_BAR; PG8_SCHED;
            PG8_LDA(At, 1, 1); PG8_STAGE(PG8_SB(1, 0), b3, voffB); PG8_STAGE(PG8_SB(1, 1), b3 + hstep, voffB); PG8_STAGE_A(PG8_SA(1, 0), a3, 0, last);
            PG8_WAIT_V(8); PG8_WAIT_L(0); PG8_BAR; PG8_MMA(1, 0, At, B0); PG8_MMA(1, 1, At, B1); PG8_BAR; PG8_SCHED;
            } else {
            PG8_LDB(B0, 0, 0); PG8_SCHED; PG8_LDA(At, 0, 0); PG8_STAGE_A(PG8_SA(1, 1), a1, 1, false);
            PG8_WAIT_L(8); PG8_BAR; PG8_WAIT_L(0); PG8_MMA(0, 0, At, B0); PG8_BAR; PG8_SCHED;
            PG8_LDB(B1, 0, 1); PG8_STAGE(PG8_SB(0, 0), b2, voffB);
            PG8_BAR; PG8_WAIT_L(0); PG8_MMA(0, 1, At, B1); PG8_BAR;
            PG8_LDA(At, 0, 1); PG8_STAGE_A(PG8_SA(0, 0), a2, 0, last);
            PG8_BAR; PG8_WAIT_L(0); PG8_MMA(1, 0, At, B0); PG8_BAR; PG8_SCHED;
            PG8_STAGE(PG8_SB(0, 1), b2 + hstep, voffB);
            PG8_WAIT_V(6); PG8_BAR; PG8_MMA(1, 1, At, B1); PG8_BAR;
            PG8_LDB(B0, 1, 0); PG8_SCHED; PG8_LDA(At, 1, 0); PG8_STAGE_A(PG8_SA(0, 1), a2, 1, last);
            PG8_WAIT_L(8); PG8_BAR; PG8_WAIT_L(0); PG8_MMA(0, 0, At, B0); PG8_BAR; PG8_SCHED;
            PG8_LDB(B1, 1, 1); PG8_STAGE(PG8_SB(1, 0), b3, voffB);
            PG8_BAR; PG8_WAIT_L(0); PG8_MMA(0, 1, At, B1); PG8_BAR;
            PG8_LDA(At, 1, 1); PG8_STAGE_A(PG8_SA(1, 0), a3, 0, last);
            PG8_BAR; PG8_WAIT_L(0); PG8_MMA(1, 0, At, B0); PG8_BAR; PG8_SCHED;
            PG8_STAGE(PG8_SB(1, 1), b3 + hstep, voffB);
            PG8_WAIT_V(6); PG8_BAR; PG8_MMA(1, 1, At, B1); PG8_BAR;
            }
        }
        if constexpr (ALIGN_EPI) { if (wr == 0) PG8_BAR; }
        E(acc, cur, wr, wc, fr, fq);
        if (!has_next) break;
#pragma unroll
        for (int a = 0; a < 2; ++a)
#pragma unroll
            for (int b = 0; b < 2; ++b)
#pragma unroll
                for (int m = 0; m < 4; ++m)
#pragma unroll
                    for (int n = 0; n < 2; ++n) acc[a][b][m][n] = (f32x4){0.f, 0.f, 0.f, 0.f};
        cur = nxt; cA = nA; cB = nB; ++ui;
        if constexpr (GATHER) {
#pragma unroll
            for (int h = 0; h < 2; ++h) { gC[h][0] = gN[h][0]; gC[h][1] = gN[h][1]; } }
        if constexpr (ALIGN_EPI) { if (wr == 1) PG8_BAR; }
    }
    PG8_WAIT_V(0);
    if constexpr (!ALIGN_EPI) { if (wr == 0) PG8_BAR; }
    PG8_BAR;
#undef PG8_SA
#undef PG8_SB
#undef PG8_STAGE
#undef PG8_STAGE2
#undef PG8_STAGE_A
#undef PG8_LDA
#undef PG8_LDB
#undef PG8_MMA
#undef PG8_WAIT_V
#undef PG8_WAIT_L
#undef PG8_BAR
#undef PG8_SCHED
}
}

constexpr int NB = 16, SEQ = 2048, D = 1024, NTOK = NB * SEQ;
constexpr int IN_COLS = 7184, NPROJ = 7168, ALR_COL = 5120;
constexpr int NEXP = 32, FF = 512, NWAVES = 8;
constexpr float DN_ALPHA = 1.189207115002721f, LN_EPS = 1e-5f, RMS_EPS = 1e-6f, QSCALE = 0.08838834764831845f;
constexpr int MAXROWS = 2 * NTOK + NEXP * 256;

constexpr size_t MiB = 1u << 20;
constexpr size_t WS_CTL = 0, CTL_ZERO_BYTES = 1 * MiB;
constexpr size_t WS_RGT = 1 * MiB;
constexpr size_t WS_TOKE = 1 * MiB + 512 * 1024;
constexpr size_t WS_TOKW = WS_TOKE + 256 * 1024;
constexpr size_t WS_ALR = 2 * MiB;
constexpr size_t WS_WR = 4 * MiB, WS_WG = 6 * MiB, WS_WO = 8 * MiB;
constexpr size_t WS_RX = 10 * MiB, WS_RY = 74 * MiB, WS_Q = 138 * MiB, WS_K = 170 * MiB, WS_V = 202 * MiB, WS_G = 266 * MiB;
constexpr size_t WS_E13 = 330 * MiB, WS_E2 = 394 * MiB;
constexpr size_t WS_XB = 426 * MiB, WS_WIN = 490 * MiB;
constexpr size_t WS_ORAW = 426 * MiB, WS_PBUF = 490 * MiB, WS_DEC = 506 * MiB, WS_SSQ = 507 * MiB;
constexpr size_t WS_ROWS = 511 * MiB;
constexpr size_t WS_MERGED = 202 * MiB;
constexpr size_t WS_Z1 = 266 * MiB;
constexpr size_t WS_TMP = 138 * MiB;
constexpr size_t WS_X1B = 10 * MiB;
constexpr size_t WS_H = 74 * MiB;
constexpr size_t WS_SLOTS = 146 * MiB;
constexpr size_t WS_END = 512 * MiB;
static_assert(WS_H + (size_t)MAXROWS * FF * 2 <= WS_SLOTS && WS_SLOTS + (size_t)2 * NTOK * D * 2 <= WS_E13 && WS_ROWS + 3 * (size_t)MAXROWS * 4 <= WS_END, "d_ws map");
constexpr int CW_BAR = 4096;
constexpr int CW_TS = 8192;
constexpr int CW_RT = 153600;
constexpr int CW_WGCNT = 131072;

constexpr int RING_BYTES = 131072, AUX_OFF = 131072, LDSCTL_OFF = 150528, LDS_BYTES = 151552;

#define XB_TMO      128
#define XB_XCNT(j)  (256  + 64 * (j))
#define XB_XSUB(j)  (1280 + 64 * (j))
#define XB_XGEN(j)  (2304 + 64 * (j))
#define XB_TOP      3328
#define XB_TOPGEN   3392
#define XCD_BAR_WORDS 3456
#define XB_SPIN_CAP (1u << 18)
__device__ __forceinline__ unsigned xb_ld(unsigned* p)              { return __hip_atomic_load(p, __ATOMIC_RELAXED, __HIP_MEMORY_SCOPE_AGENT); }
__device__ __forceinline__ unsigned xb_add(unsigned* p, unsigned v) { return __hip_atomic_fetch_add(p, v, __ATOMIC_RELAXED, __HIP_MEMORY_SCOPE_AGENT); }
__device__ __forceinline__ unsigned xb_xcc_id() { return (unsigned)__builtin_amdgcn_s_getreg((3 << 11) | 20) & 0xFu; }
#define XB_SPIN(cond, bar) do { unsigned _sp = 0; while (cond) { __builtin_amdgcn_s_sleep(1); \
    if ((++_sp & 255u) == 0u) { if (xb_ld(&(bar)[XB_TMO])) break; if (_sp > XB_SPIN_CAP) { atomicAdd(&(bar)[XB_TMO], 1u); break; } } } } while (0)
struct XcdBarrier { unsigned* bar; unsigned x; volatile LAS unsigned* st; };
__device__ __forceinline__ XcdBarrier xcd_barrier_post(unsigned* bar, volatile LAS unsigned* st) {
    XcdBarrier b; b.bar = bar; b.x = xb_xcc_id(); b.st = st;
    if (threadIdx.x == 0) (void)xb_add(&bar[XB_XCNT(b.x)], 1u);
    return b;
}
__device__ __forceinline__ void xcd_barrier_complete(unsigned* bar, unsigned x, unsigned& nloc, unsigned& nx) {
    const unsigned G = gridDim.x * gridDim.y * gridDim.z;
    unsigned sum, cnt, mine, sp = 0u;
    for (;;) {
        sum = 0u; cnt = 0u; mine = 0u;
#pragma unroll
        for (unsigned j = 0; j < 16; ++j) { const unsigned c = xb_ld(&bar[XB_XCNT(j)]); sum += c; cnt += (c > 0u) ? 1u : 0u; mine = (j == x) ? c : mine; }
        if (sum == G) break;
        __builtin_amdgcn_s_sleep(1);
        if ((++sp & 255u) == 0u) { if (xb_ld(&bar[XB_TMO])) break; if (sp > XB_SPIN_CAP) { atomicAdd(&bar[XB_TMO], 1u); break; } }
    }
    nloc = mine > 0u ? mine : 1u; nx = cnt > 0u ? cnt : 1u;
}
__device__ __forceinline__ void xcd_barrier(const XcdBarrier& b) {
    asm volatile("s_waitcnt vmcnt(0)" ::: "memory");
    __syncthreads();
    if (threadIdx.x == 0) {
        unsigned* bar = b.bar;
        __builtin_amdgcn_s_waitcnt(0);
        unsigned nloc = b.st[0], nx = b.st[1];
        if (nloc == 0u) { xcd_barrier_complete(bar, b.x, nloc, nx); b.st[0] = nloc; b.st[1] = nx; }
        const unsigned old = xb_add(&bar[XB_XSUB(b.x)], 1u);
        const unsigned gen = old / nloc;
        if (old + 1u == (gen + 1u) * nloc) {
            __builtin_amdgcn_fence(__ATOMIC_RELEASE, "agent");
            asm volatile("s_waitcnt vmcnt(0)" ::: "memory");
            const unsigned og = xb_add(&bar[XB_TOP], 1u);
            const unsigned tg = og / nx;
            if (og + 1u == (tg + 1u) * nx) xb_add(&bar[XB_TOPGEN], 1u);
            else XB_SPIN(xb_ld(&bar[XB_TOPGEN]) == tg, bar);
            __builtin_amdgcn_fence(__ATOMIC_ACQUIRE, "agent");
            xb_add(&bar[XB_XGEN(b.x)], 1u);
            asm volatile("s_waitcnt vmcnt(0)" ::: "memory");
        } else {
            XB_SPIN(xb_ld(&bar[XB_XGEN(b.x)]) == gen, bar);
            __builtin_amdgcn_fence(__ATOMIC_ACQUIRE, "agent");
            asm volatile("s_waitcnt vmcnt(0)" ::: "memory");
        }
    }
    __syncthreads();
}

struct Frame {
    LAS unsigned char* lds;
    unsigned* ctl;
    int tid, lane, wave, vcu, G;
    float* out;
    unsigned char* ws;
};
struct Args { const float* in[28]; float* out; unsigned char* ws; int ph_lo, ph_hi, dup, pad; };
enum InIdx { I_X = 0, I_WIN, I_BIN, I_CONVW, I_CONVB, I_RGWA, I_RGBA, I_RGWX, I_RGBX, I_LAM, I_GWA2, I_GBA, I_GNORM, I_WPR, I_WPG, I_WO, I_BO, I_LN1G, I_LN1B,
             I_RWG, I_RBG, I_RWE, I_RBE, I_EW1, I_EW3, I_EW2, I_LN2G, I_LN2B };
template <class T> DI T* wsp(Frame& F, size_t off) { return (T*)(F.ws + off); }

template <int CTRL, int RM> DI float dpp_mov0(float v) { return __builtin_bit_cast(float, __builtin_amdgcn_update_dpp(0, __builtin_bit_cast(int, v), CTRL, RM, 0xF, false)); }
DI float wave_sum(float v) {
    v += dpp_mov0<0xB1, 0xF>(v);
    v += dpp_mov0<0x4E, 0xF>(v);
    v += dpp_mov0<0x141, 0xF>(v);
    v += dpp_mov0<0x140, 0xF>(v);
    v += dpp_mov0<0x142, 0xA>(v);
    v += dpp_mov0<0x143, 0xC>(v);
    return __builtin_bit_cast(float, __builtin_amdgcn_readlane(__builtin_bit_cast(int, v), 63));
}
DI int idx16(int lane) { return ((lane >> 5) & 1) * 8 + ((lane >> 4) & 1) * 4 + ((lane >> 3) & 1) * 2 + ((lane >> 2) & 1); }
DI float reduce16(const float (&a)[16], int lane) {
    float b[8], c[4], d[2];
    { const bool hi = (lane & 32) != 0;
#pragma unroll
      for (int i = 0; i < 8; ++i) { const float keep = hi ? a[i + 8] : a[i], send = hi ? a[i] : a[i + 8]; b[i] = keep + __shfl_xor(send, 32); } }
    { const bool hi = (lane & 16) != 0;
#pragma unroll
      for (int i = 0; i < 4; ++i) { const float keep = hi ? b[i + 4] : b[i], send = hi ? b[i] : b[i + 4]; c[i] = keep + __shfl_xor(send, 16); } }
    { const bool hi = (lane & 8) != 0;
#pragma unroll
      for (int i = 0; i < 2; ++i) { const float keep = hi ? c[i + 2] : c[i], send = hi ? c[i] : c[i + 2]; d[i] = keep + __shfl_xor(send, 8); } }
    float e; { const bool hi = (lane & 4) != 0; const float keep = hi ? d[1] : d[0], send = hi ? d[0] : d[1]; e = keep + __shfl_xor(send, 4); }
    e += __shfl_xor(e, 2); e += __shfl_xor(e, 1);
    return e;
}

DI void transpose_item(const float* src, int ld_src, bf16_t* dst, int ld_dst, LAS float* scr, int lane) {
    f32x4 v[8];
#pragma unroll
    for (int i = 0; i < 8; ++i) v[i] = *(const f32x4*)(src + (size_t)((lane >> 3) + 8 * i) * ld_src + 4 * (lane & 7));
#pragma unroll
    for (int i = 0; i < 8; ++i) { LAS float* p = scr + ((lane >> 3) + 8 * i) * 33 + 4 * (lane & 7); p[0] = v[i].x; p[1] = v[i].y; p[2] = v[i].z; p[3] = v[i].w; }
    LDS_WAIT(); asm volatile("" ::: "memory");
    const int c = lane & 7;
#pragma unroll
    for (int j = 0; j < 4; ++j) { const int n = (lane >> 3) + 8 * j; const LAS float* s = scr + (8 * c) * 33 + n;
        u32x4 o; o.x = cvt_pk_bf16(s[0 * 33], s[1 * 33]); o.y = cvt_pk_bf16(s[2 * 33], s[3 * 33]); o.z = cvt_pk_bf16(s[4 * 33], s[5 * 33]); o.w = cvt_pk_bf16(s[6 * 33], s[7 * 33]);
        *(u32x4*)(dst + (size_t)n * ld_dst + 8 * c) = o; }
    LDS_WAIT(); asm volatile("" ::: "memory");
}
DI void p0_prologue(Frame& F, const Args& A) {
    LAS float* scr = (LAS float*)(F.lds + F.wave * 8704);
    LAS float* walr = (LAS float*)(F.lds + 81920);
    const int gw = F.vcu * NWAVES + F.wave, NGW = F.G * NWAVES, lane = F.lane;
    const float* w_in = A.in[I_WIN];
    if (F.vcu < 36) {
        const int n = F.vcu; bf16_t* thi = (bf16_t*)(F.ctl + CW_RT); bf16_t* tlo = thi + 36 * 1024; float* tsw = (float*)(F.ctl + CW_RT + 36864);
        LAS float* red = (LAS float*)(F.lds + LDSCTL_OFF + 512);
        float ps = 0.f, pc = 0.f;
#pragma unroll
        for (int i = 0; i < 2; ++i) { const int k = F.tid + 512 * i; const float wv = (n < 32) ? A.in[I_RWE][k * 32 + n] : A.in[I_RWG][k * 4 + (n - 32)];
            const float wp = A.in[I_LN1G][k] * wv; const unsigned short hi = f2bf(wp); const unsigned short lo = f2bf(wp - bf2f(hi));
            thi[n * 1024 + k] = hi; tlo[n * 1024 + k] = lo; ps += bf2f(hi) + bf2f(lo); pc += A.in[I_LN1B][k] * wv; }
        ps = wave_sum(ps); pc = wave_sum(pc);
        if (lane == 0) { red[F.wave] = ps; red[8 + F.wave] = pc; }
        __syncthreads();
        if (F.tid == 0) { float a = 0.f, c = 0.f;
#pragma unroll
            for (int i = 0; i < 8; ++i) { a += red[i]; c += red[8 + i]; }
            tsw[n] = a; tsw[48 + n] = c + ((n < 32) ? A.in[I_RBE][n] : A.in[I_RBG][n - 32]); }
    }
    for (int i = F.tid; i < 16 * 1024; i += NWAVES * 64) { const int k = i >> 4, r = i & 15; walr[r * 1028 + k] = w_in[(size_t)k * IN_COLS + ALR_COL + r]; }
    __syncthreads();
    constexpr int N_WIN = 16 * 224, N_SQ = 3 * 512, N_RG = 128, N_E13 = 32 * 512, N_E2 = 32 * 256;
    constexpr int NITEMS = N_WIN + N_SQ + N_RG + N_E13 + N_E2;
    for (int rep_ = 0; rep_ < 1 + ((MK_DUP >> 13) & 1); ++rep_)
    for (int it0 = gw; it0 < NITEMS; it0 += NGW) {
        int it = it0;
        if (it < N_WIN) { const int kb = it / 224, nb = it % 224, n0 = 32 * nb, sc = n0 + (n0 >= ALR_COL ? 16 : 0);
            transpose_item(w_in + (size_t)(64 * kb) * IN_COLS + sc, IN_COLS, wsp<bf16_t>(F, WS_WIN) + (size_t)n0 * 1024 + 64 * kb, 1024, scr, lane); continue; }
        it -= N_WIN;
        if (it < N_SQ) { const int mat = it / 512, r = it % 512, kb = r / 32, nb = r % 32;
            const size_t so = (size_t)(64 * kb) * 1024 + 32 * nb, dof = (size_t)(32 * nb) * 1024 + 64 * kb;
            if (mat == 0) transpose_item(A.in[I_WPR] + so, 1024, wsp<bf16_t>(F, WS_WR) + dof, 1024, scr, lane);
            else if (mat == 1) transpose_item(A.in[I_WPG] + so, 1024, wsp<bf16_t>(F, WS_WG) + dof, 1024, scr, lane);
            else transpose_item(A.in[I_WO] + so, 1024, wsp<bf16_t>(F, WS_WO) + dof, 1024, scr, lane);
            continue; }
        it -= N_SQ;
        if (it < N_RG) { const int bg = it / 8, r = it % 8, kb = r / 4, nb = r % 4, blk = bg >> 1, gate = bg & 1;
            const size_t so = (size_t)blk * 16384 + (64 * kb) * 128 + 32 * nb; bf16_t* dp = wsp<bf16_t>(F, WS_RGT) + (size_t)bg * 16384 + (32 * nb) * 128 + 64 * kb;
            if (gate) transpose_item(A.in[I_RGWX] + so, 128, dp, 128, scr, lane); else transpose_item(A.in[I_RGWA] + so, 128, dp, 128, scr, lane);
            continue; }
        it -= N_RG;
        if (it < N_E13) { const int e = it / 512, r = it % 512, which = r / 256, r2 = r % 256, kb = r2 / 16, nb = r2 % 16, n0 = 32 * nb;
            const int nd = 256 * (n0 / 128) + 128 * which + (n0 % 128);
            const size_t so = (size_t)e * (1024 * 512) + (size_t)(64 * kb) * 512 + n0; bf16_t* dp = wsp<bf16_t>(F, WS_E13) + (size_t)e * (1024 * 1024) + (size_t)nd * 1024 + 64 * kb;
            if (which) transpose_item(A.in[I_EW3] + so, 512, dp, 1024, scr, lane); else transpose_item(A.in[I_EW1] + so, 512, dp, 1024, scr, lane);
            continue; }
        it -= N_E13;
        { const int e = it / 256, r = it % 256, kb = r / 32, nb = r % 32;
            const float* W = A.in[I_EW2] + (size_t)e * (512 * 1024);
            transpose_item(W + (size_t)(64 * kb) * 1024 + 32 * nb, 1024, wsp<bf16_t>(F, WS_E2) + (size_t)e * (1024 * 512) + (size_t)(32 * nb) * 512 + 64 * kb, 512, scr, lane); }
    }
    const float* x = A.in[I_X]; bf16_t* xb = wsp<bf16_t>(F, WS_XB); float* alr = wsp<float>(F, WS_ALR);
    const float balr = A.in[I_BIN][ALR_COL + idx16(lane)];
    for (int rep_ = 0; rep_ < 1 + ((MK_DUP >> 14) & 1); ++rep_)
    for (int m = 2 * gw; m < NTOK; m += 2 * NGW) {
        f32x4 xv[2][4];
#pragma unroll
        for (int r = 0; r < 2; ++r)
#pragma unroll
            for (int j = 0; j < 4; ++j) xv[r][j] = *((const f32x4*)(x + (size_t)(m + r) * D) + lane + 64 * j);
#pragma unroll
        for (int r = 0; r < 2; ++r)
#pragma unroll
            for (int j = 0; j < 4; ++j) { u32x2 w; w.x = cvt_pk_bf16(xv[r][j].x, xv[r][j].y); w.y = cvt_pk_bf16(xv[r][j].z, xv[r][j].w);
                *(u32x2*)(xb + (size_t)(m + r) * D + 4 * lane + 256 * j) = w; }
        float a0[16], a1[16];
#pragma unroll
        for (int rr = 0; rr < 16; ++rr) { a0[rr] = 0.f; a1[rr] = 0.f; }
#pragma unroll
        for (int j = 0; j < 4; ++j) {
#pragma unroll
            for (int rr = 0; rr < 16; ++rr) { const f32x4 wv = *(const LAS f32x4*)(walr + rr * 1028 + 256 * j + 4 * lane);
                a0[rr] += xv[0][j].x * wv.x + xv[0][j].y * wv.y + xv[0][j].z * wv.z + xv[0][j].w * wv.w;
                a1[rr] += xv[1][j].x * wv.x + xv[1][j].y * wv.y + xv[1][j].z * wv.z + xv[1][j].w * wv.w; }
            __builtin_amdgcn_sched_barrier(0); }
        const float t0 = reduce16(a0, lane) + balr, t1 = reduce16(a1, lane) + balr;
        if ((lane & 3) == 0) { alr[(size_t)m * 16 + idx16(lane)] = t0; alr[(size_t)(m + 1) * 16 + idx16(lane)] = t1; }
    }
}

using pg8::Unit;
struct EpiProj {
    static constexpr bool PERM = true;
    bf16_t *rx, *ry, *q, *k, *v, *g, *ga, *gb; const float* bias;
    DI void operator()(const f32x4 (&acc)[2][2][4][2], const Unit& u, int wr, int wc, int fr, int fq) const {
        const int pn = u.pn; bf16_t* base; int ldc = 1024, ct;
        if (pn < 4) { base = rx; ct = pn; } else if (pn < 8) { base = ry; ct = pn - 4; } else if (pn < 10) { base = q; ldc = 512; ct = pn - 8; } else if (pn < 12) { base = k; ldc = 512; ct = pn - 10; }
        else if (pn < 16) { base = v; ct = pn - 12; } else if (pn < 20) { base = g; ct = pn - 16; } else if (pn < 24) { base = ga; ct = pn - 20; } else { base = gb; ct = pn - 24; }
        const int row0 = u.pm * 256 + wr * 64 + fr, col0 = ct * 256 + wc * 32 + 8 * fq, bcol0 = pn * 256 + (pn >= 20 ? 16 : 0) + wc * 32 + 8 * fq;
        f32x4 bv[2][2];
#pragma unroll
        for (int bj = 0; bj < 2; ++bj)
#pragma unroll
            for (int n = 0; n < 2; ++n) bv[bj][n] = *(const f32x4*)(bias + bcol0 + bj * 128 + 4 * n);
#pragma unroll
        for (int ai = 0; ai < 2; ++ai)
#pragma unroll
            for (int m = 0; m < 4; ++m) { bf16_t* rowp = base + (size_t)(row0 + ai * 128 + m * 16) * ldc + col0;
#pragma unroll
                for (int bj = 0; bj < 2; ++bj) { const f32x4 v0 = acc[ai][bj][m][0] + bv[bj][0], v1 = acc[ai][bj][m][1] + bv[bj][1];
                    u32x4 w; w.x = cvt_pk_bf16(v0[0], v0[1]); w.y = cvt_pk_bf16(v0[2], v0[3]); w.z = cvt_pk_bf16(v1[0], v1[1]); w.w = cvt_pk_bf16(v1[2], v1[3]);
                    *(u32x4*)(rowp + bj * 128) = w; } }
    }
};
DI void launder(u32x4& v) { asm volatile("" : "+v"(v.x), "+v"(v.y), "+v"(v.z), "+v"(v.w)); }
DI void unpack8(const u32x4 w, float (&f)[8]) { f[0] = bf_lo(w.x); f[1] = bf_hi(w.x); f[2] = bf_lo(w.y); f[3] = bf_hi(w.y); f[4] = bf_lo(w.z); f[5] = bf_hi(w.z); f[6] = bf_lo(w.w); f[7] = bf_hi(w.w); }
struct EpiMergeA {
    static constexpr bool PERM = true;
    const bf16_t* ga; bf16_t* tmp;
    DI void operator()(const f32x4 (&acc)[2][2][4][2], const Unit& u, int wr, int wc, int fr, int fq) const {
        const int row0 = u.pm * 256 + wr * 64 + fr, col0 = u.pn * 256 + wc * 32 + 8 * fq;
        u32x4 gq[2][4][2];
#pragma unroll
        for (int ai = 0; ai < 2; ++ai)
#pragma unroll
            for (int m = 0; m < 4; ++m)
#pragma unroll
                for (int bj = 0; bj < 2; ++bj) gq[ai][m][bj] = *(const u32x4*)(ga + (size_t)(row0 + ai * 128 + m * 16) * D + col0 + bj * 128);
#pragma unroll
        for (int ai = 0; ai < 2; ++ai)
#pragma unroll
            for (int m = 0; m < 4; ++m) { const size_t off = (size_t)(row0 + ai * 128 + m * 16) * D + col0;
#pragma unroll
                for (int bj = 0; bj < 2; ++bj) { float gf[8]; unpack8(gq[ai][m][bj], gf);
                    f32x4 o0, o1;
#pragma unroll
                    for (int j = 0; j < 4; ++j) { o0[j] = sigmoid_f(gf[j]) * acc[ai][bj][m][0][j]; o1[j] = sigmoid_f(gf[4 + j]) * acc[ai][bj][m][1][j]; }
                    u32x4 w; w.x = cvt_pk_bf16(o0[0], o0[1]); w.y = cvt_pk_bf16(o0[2], o0[3]); w.z = cvt_pk_bf16(o1[0], o1[1]); w.w = cvt_pk_bf16(o1[2], o1[3]);
                    *(u32x4*)(tmp + off + bj * 128) = w; } }
    }
};
struct RowHook { static constexpr bool ACTIVE = true;
    const LAS float* rs;
    DI bool wants(int t) const { return t == 4 || t == 8 || t == 12; }
    DI void apply(int t, f32x4 (&acc)[2][2][4][2], const Unit& u, int wr, int wc, int fr, int fq) const {
        const int h = t >> 2;
#pragma unroll
        for (int ai = 0; ai < 2; ++ai)
#pragma unroll
            for (int m = 0; m < 4; ++m) { const f32x4 r4 = *(const LAS f32x4*)(rs + ((u.e & 1) * 256 + ai * 128 + wr * 64 + m * 16 + fr) * 4);
                const float f = (h == 1 ? r4[0] : (h == 2 ? r4[1] : r4[2])) * fast_rcp(h == 1 ? r4[1] : (h == 2 ? r4[2] : r4[3]));
#pragma unroll
                for (int bj = 0; bj < 2; ++bj) { acc[ai][bj][m][0] = acc[ai][bj][m][0] * f; acc[ai][bj][m][1] = acc[ai][bj][m][1] * f; } }
    }
};
struct EpiMergeB {
    static constexpr bool PERM = true;
    const bf16_t* gb; const bf16_t* tmp; bf16_t* merged; const LAS float* rs;
    DI void operator()(const f32x4 (&acc)[2][2][4][2], const Unit& u, int wr, int wc, int fr, int fq) const {
        const int row0 = u.pm * 256 + wr * 64 + fr, col0 = u.pn * 256 + wc * 32 + 8 * fq;
#pragma unroll
        for (int ai = 0; ai < 2; ++ai) {
            u32x4 gq[4][2], tq[4][2];
#pragma unroll
            for (int m = 0; m < 4; ++m)
#pragma unroll
                for (int bj = 0; bj < 2; ++bj) { const size_t off = (size_t)(row0 + ai * 128 + m * 16) * D + col0 + bj * 128; gq[m][bj] = *(const u32x4*)(gb + off); tq[m][bj] = *(const u32x4*)(tmp + off); }
#pragma unroll
            for (int m = 0; m < 4; ++m) { const size_t off = (size_t)(row0 + ai * 128 + m * 16) * D + col0; const float rl = rs[((u.e & 1) * 256 + ai * 128 + wr * 64 + m * 16 + fr) * 4 + 3];
#pragma unroll
                for (int bj = 0; bj < 2; ++bj) { float gf[8], tf[8]; unpack8(gq[m][bj], gf); unpack8(tq[m][bj], tf);
                    f32x4 o0, o1;
#pragma unroll
                    for (int j = 0; j < 4; ++j) { o0[j] = tf[j] + acc[ai][bj][m][0][j] * sigmoid_f(gf[j]) * rl; o1[j] = tf[4 + j] + acc[ai][bj][m][1][j] * sigmoid_f(gf[4 + j]) * rl; }
                    u32x4 w; w.x = cvt_pk_bf16(o0[0], o0[1]); w.y = cvt_pk_bf16(o0[2], o0[3]); w.z = cvt_pk_bf16(o1[0], o1[1]); w.w = cvt_pk_bf16(o1[2], o1[3]);
                    *(u32x4*)(merged + off + bj * 128) = w; } }
            __builtin_amdgcn_sched_barrier(0); }
    }
};
struct EpiWo {
    static constexpr bool PERM = true;
    const bf16_t* xb; const float* bo; bf16_t* z;
    DI void operator()(const f32x4 (&acc)[2][2][4][2], const Unit& u, int wr, int wc, int fr, int fq) const {
        const int row0 = u.pm * 256 + wr * 64 + fr, col0 = u.pn * 256 + wc * 32 + 8 * fq;
        f32x4 bv[2][2];
#pragma unroll
        for (int bj = 0; bj < 2; ++bj)
#pragma unroll
            for (int n = 0; n < 2; ++n) bv[bj][n] = *(const f32x4*)(bo + col0 + bj * 128 + 4 * n);
        u32x4 xq[2][4][2];
#pragma unroll
        for (int ai = 0; ai < 2; ++ai)
#pragma unroll
            for (int m = 0; m < 4; ++m)
#pragma unroll
                for (int bj = 0; bj < 2; ++bj) xq[ai][m][bj] = *(const u32x4*)(xb + (size_t)(row0 + ai * 128 + m * 16) * D + col0 + bj * 128);
#pragma unroll
        for (int ai = 0; ai < 2; ++ai)
#pragma unroll
            for (int m = 0; m < 4; ++m) { const size_t off = (size_t)(row0 + ai * 128 + m * 16) * D + col0;
#pragma unroll
                for (int bj = 0; bj < 2; ++bj) { float xf[8]; unpack8(xq[ai][m][bj], xf);
                    f32x4 o0, o1;
#pragma unroll
                    for (int j = 0; j < 4; ++j) { o0[j] = xf[j] * DN_ALPHA + acc[ai][bj][m][0][j] + bv[bj][0][j]; o1[j] = xf[4 + j] * DN_ALPHA + acc[ai][bj][m][1][j] + bv[bj][1][j]; }
                    u32x4 w; w.x = cvt_pk_bf16(o0[0], o0[1]); w.y = cvt_pk_bf16(o0[2], o0[3]); w.z = cvt_pk_bf16(o1[0], o1[1]); w.w = cvt_pk_bf16(o1[2], o1[3]);
                    *(u32x4*)(z + off + bj * 128) = w; } }
    }
};
struct EpiExp1 {
    static constexpr bool PERM = true;
    bf16_t* h;
    DI void operator()(const f32x4 (&acc)[2][2][4][2], const Unit& u, int wr, int wc, int fr, int fq) const {
        const int row0 = u.pm * 256 + wr * 64 + fr, col0 = u.pn * 128 + wc * 32 + 8 * fq;
#pragma unroll
        for (int ai = 0; ai < 2; ++ai)
#pragma unroll
            for (int m = 0; m < 4; ++m) { f32x4 o0, o1;
#pragma unroll
                for (int j = 0; j < 4; ++j) { o0[j] = silu_f(acc[ai][0][m][0][j]) * acc[ai][1][m][0][j]; o1[j] = silu_f(acc[ai][0][m][1][j]) * acc[ai][1][m][1][j]; }
                u32x4 w; w.x = cvt_pk_bf16(o0[0], o0[1]); w.y = cvt_pk_bf16(o0[2], o0[3]); w.z = cvt_pk_bf16(o1[0], o1[1]); w.w = cvt_pk_bf16(o1[2], o1[3]);
                *(u32x4*)(h + (size_t)(row0 + ai * 128 + m * 16) * FF + col0) = w; }
    }
};
struct EpiExp2 {
    static constexpr bool PERM = true;
    const int* row_slot; const float* row_w; bf16_t* slots;
    DI void operator()(const f32x4 (&acc)[2][2][4][2], const Unit& u, int wr, int wc, int fr, int fq) const {
        const int row0 = u.pm * 256 + wr * 64 + fr, col0 = u.pn * 256 + wc * 32 + 8 * fq;
        int sl[8]; float wl[8];
#pragma unroll
        for (int q = 0; q < 8; ++q) { const int r = row0 + (q >> 2) * 128 + (q & 3) * 16; sl[q] = row_slot[r]; wl[q] = row_w[r]; }
#pragma unroll
        for (int ai = 0; ai < 2; ++ai)
#pragma unroll
            for (int m = 0; m < 4; ++m) { const int slot = sl[ai * 4 + m]; const float w8 = wl[ai * 4 + m];
                if (slot >= 0) {
#pragma unroll
                    for (int bj = 0; bj < 2; ++bj) { const f32x4 v0 = acc[ai][bj][m][0] * w8, v1 = acc[ai][bj][m][1] * w8;
                        u32x4 w; w.x = cvt_pk_bf16(v0[0], v0[1]); w.y = cvt_pk_bf16(v0[2], v0[3]); w.z = cvt_pk_bf16(v1[0], v1[1]); w.w = cvt_pk_bf16(v1[2], v1[3]);
                        *(u32x4*)(slots + (size_t)slot * D + col0 + bj * 128) = w; } } }
    }
};
struct MoeOrder {
    const char* A; const char* Bt; int K; size_t bstride; const LAS int* ts; const int* row_tok; int G, c, gather;
    DI bool next(int i, Unit& u) const {
        const int L = i * G + c, ntile = ts[32]; if (L >= 4 * ntile) return false;
        const int tile = L >> 2, lane = threadIdx.x & 63;
        const int v = ts[lane < 32 ? lane + 1 : 32];
        const unsigned long long mk = __ballot(lane < 32 && v <= tile);
        u.pm = tile; u.pn = L & 3; u.e = __builtin_amdgcn_readfirstlane((int)__popcll(mk)); return true;
    }
    DI const char* a_ptr(const Unit& u) const { return gather ? A : A + (size_t)u.pm * 256 * K * 2; }
    DI const char* b_ptr(const Unit& u) const { return Bt + (size_t)u.e * bstride + (size_t)u.pn * 256 * K * 2; }
    DI void a_rows(const Unit& u, const int (&RA)[2], const int (&CA)[2], unsigned (&g)[2][2]) const {
#pragma unroll
        for (int h = 0; h < 2; ++h)
#pragma unroll
            for (int i = 0; i < 2; ++i) g[h][i] = (unsigned)row_tok[u.pm * 256 + h * 128 + RA[i]] * (unsigned)(K * 2) + (unsigned)CA[i];
    }
};

DI void phase_gla_pre(Frame& F, const Args& A, const bool dry) {
    LAS unsigned char* L = F.lds;
    constexpr int oQT = 0, oKT = 17408, oKE = 34816, oALR = 52224, oSEG = 56320, RS = 272;
    const int tid = F.tid, lane = F.lane, w = F.wave, kk = tid & 127, seg = tid >> 7, g = lane >> 4, fr = lane & 15;
    bf16_t* Q = wsp<bf16_t>(F, WS_Q); bf16_t* K = wsp<bf16_t>(F, WS_K); const float* ALR = wsp<float>(F, WS_ALR);
    bf16_t* PB = wsp<bf16_t>(F, WS_PBUF); float* DEC = wsp<float>(F, WS_DEC);
    u32x4 nq[2], nk[2]; f32x4 na = {0.f, 0.f, 0.f, 0.f};
#define GP_LOAD(item_) do { const int b_ = (item_) >> 7, hd_ = ((item_) >> 5) & 3, n_ = (item_) & 31; const size_t t0_ = (size_t)b_ * SEQ + n_ * 64; \
        _Pragma("unroll") for (int i_ = 0; i_ < 2; ++i_) { const int c_ = tid + 512 * i_, row_ = c_ >> 4, c16_ = c_ & 15; const size_t go_ = (t0_ + row_) * 512 + hd_ * 128 + c16_ * 8; nq[i_] = *(const u32x4*)(Q + go_); nk[i_] = *(const u32x4*)(K + go_); } \
        if (tid < 256) na = *(const f32x4*)(ALR + t0_ * 16 + tid * 4); } while (0)
    if (F.vcu < NB * 4 * 32) GP_LOAD(F.vcu);
    int hd_prev = -1; float w2[16]; float ba = 0.f;
    for (int item = F.vcu; item < NB * 4 * 32; item += F.G) {
        const int b = item >> 7, hd = (item >> 5) & 3, n = item & 31;
        const size_t tok0 = (size_t)b * SEQ + n * 64;
        if (hd != hd_prev) { hd_prev = hd;
#pragma unroll
            for (int r = 0; r < 16; ++r) w2[r] = A.in[I_GWA2][r * 512 + hd * 128 + kk];
            ba = A.in[I_GBA][hd * 128 + kk]; }
        LDS_BARRIER();
#pragma unroll
        for (int i = 0; i < 2; ++i) { const int c = tid + 512 * i, row = c >> 4, c16 = c & 15;
            *(LAS u32x4*)(L + oQT + row * RS + c16 * 16) = nq[i]; *(LAS u32x4*)(L + oKT + row * RS + c16 * 16) = nk[i]; }
        if (tid < 256) *(LAS f32x4*)(L + oALR + tid * 16) = na;
        if (item + F.G < NB * 4 * 32) GP_LOAD(item + F.G);
        LDS_BARRIER();
        float cs[16]; float run = 0.f;
#pragma unroll
        for (int i = 0; i < 16; ++i) { const LAS f32x4* ar = (const LAS f32x4*)(L + oALR + (16 * seg + i) * 64); const f32x4 a0 = ar[0], a1 = ar[1], a2 = ar[2], a3 = ar[3];
            float z = ba + a0.x * w2[0] + a0.y * w2[1] + a0.z * w2[2] + a0.w * w2[3] + a1.x * w2[4] + a1.y * w2[5] + a1.z * w2[6] + a1.w * w2[7]
                         + a2.x * w2[8] + a2.y * w2[9] + a2.z * w2[10] + a2.w * w2[11] + a3.x * w2[12] + a3.y * w2[13] + a3.z * w2[14] + a3.w * w2[15];
            const float la = (fminf(z, 0.f) - __logf(1.0f + fast_exp(-fabsf(z)))) * (1.0f / 16.0f);
            run += la; cs[i] = run; }
        LAS float* SEGp = (LAS float*)(L + oSEG);
        SEGp[seg * 128 + kk] = run;
        LDS_BARRIER();
        float off = 0.f, bl = 0.f;
#pragma unroll
        for (int s = 0; s < 4; ++s) { const float v = SEGp[s * 128 + kk]; bl += v; off += (s < seg) ? v : 0.f; }
        const float eb = fast_exp(bl);
#pragma unroll
        for (int i = 0; i < 16; ++i) { const int t = 16 * seg + i; const float E = fast_exp(off + cs[i]), Ei = fast_rcp(E);
            LAS unsigned short* qp = (LAS unsigned short*)(L + oQT + t * RS) + kk; LAS unsigned short* kp = (LAS unsigned short*)(L + oKT + t * RS) + kk; LAS unsigned short* ep = (LAS unsigned short*)(L + oKE + t * RS) + kk;
            const float qv = bf2f(*qp), kv = bf2f(*kp);
            *qp = f2bf(qv * QSCALE * E); *kp = f2bf(kv * Ei); *ep = f2bf(kv * Ei * eb); }
        if (seg == 0) DEC[(size_t)item * 128 + kk] = eb;
        LDS_BARRIER();
        const int tt = w >> 1;
#pragma unroll
        for (int j = 0; j < 2; ++j) { const int st = 2 * (w & 1) + j; f32x4 acc = {0.f, 0.f, 0.f, 0.f};
#pragma unroll
            for (int ks = 0; ks < 4; ++ks) { const bf16x8 a = *(const LAS bf16x8*)(L + oKT + (16 * st + fr) * RS + (32 * ks + 8 * g) * 2); const bf16x8 bq = *(const LAS bf16x8*)(L + oQT + (16 * tt + fr) * RS + (32 * ks + 8 * g) * 2);
                acc = MFMA16(a, bq, acc); }
            const int t = 16 * tt + fr, s0 = 16 * st + 4 * g;
            u32x2 o; o.x = cvt_pk_bf16(s0 + 0 <= t ? acc[0] : 0.f, s0 + 1 <= t ? acc[1] : 0.f); o.y = cvt_pk_bf16(s0 + 2 <= t ? acc[2] : 0.f, s0 + 3 <= t ? acc[3] : 0.f);
            if (!dry) *(u32x2*)(PB + (size_t)item * 4096 + t * 64 + s0) = o; }
#pragma unroll
        for (int c = tid; c < 1024; c += 512) { const int row = c >> 4, c16 = c & 15; const size_t go = (tok0 + row) * 512 + hd * 128 + c16 * 8;
            const u32x4 q_ = *(const LAS u32x4*)(L + oQT + row * RS + c16 * 16), k_ = *(const LAS u32x4*)(L + oKE + row * RS + c16 * 16); if (!dry) { *(u32x4*)(Q + go) = q_; *(u32x4*)(K + go) = k_; } }
    }
#undef GP_LOAD
}

DI bf16x8 tr_pair(const LAS unsigned char* p, int rowstride4) {
    const s16x4 lo = __builtin_amdgcn_ds_read_tr16_b64_v4i16((LAS s16x4*)p);
    const s16x4 hi = __builtin_amdgcn_ds_read_tr16_b64_v4i16((LAS s16x4*)(p + rowstride4));
    return __builtin_shufflevector(lo, hi, 0, 1, 2, 3, 4, 5, 6, 7);
}
DI void phase_gla_chain(Frame& F, const Args& A) {
    LAS unsigned char* L = F.lds;
    constexpr int BUF = 53760, oQD = 0, oKE = 17408, oV = 34816, oP = 44032, oDEC = 53248, oST = 2 * BUF, RS = 272, RV = 144;
    const int tid = F.tid, lane = F.lane, w = F.wave, g = lane >> 4, fr = lane & 15, q4 = fr >> 2, p4 = fr & 3;
    const bf16_t* Q = wsp<bf16_t>(F, WS_Q); const bf16_t* K = wsp<bf16_t>(F, WS_K); const bf16_t* V = wsp<bf16_t>(F, WS_V);
    const bf16_t* PB = wsp<bf16_t>(F, WS_PBUF); const float* DEC = wsp<float>(F, WS_DEC);
    bf16_t* GB = wsp<bf16_t>(F, WS_G); float* SSQ = wsp<float>(F, WS_SSQ);
    for (int chain = F.vcu; chain < 256; chain += F.G) {
        const int b = chain >> 4, hd = (chain >> 2) & 3, vs = chain & 3;
        const int item0 = b * 128 + hd * 32; const size_t tokb = (size_t)b * SEQ;
        f32x4 S[4];
#pragma unroll
        for (int i = 0; i < 4; ++i) S[i] = (f32x4){0.f, 0.f, 0.f, 0.f};
        u32x4 pq[2], pk[2], pv, pp; float pd = 0.f;
        const int r16 = tid >> 4, c16 = tid & 15, r8 = tid >> 3, c8 = tid & 7;
#define GC_LOAD(n_) do { const size_t t0_ = tokb + (size_t)(n_) * 64; const int it_ = item0 + (n_); \
            pq[0] = *(const u32x4*)(Q + (t0_ + r16) * 512 + hd * 128 + c16 * 8); pq[1] = *(const u32x4*)(Q + (t0_ + r16 + 32) * 512 + hd * 128 + c16 * 8); \
            pk[0] = *(const u32x4*)(K + (t0_ + r16) * 512 + hd * 128 + c16 * 8); pk[1] = *(const u32x4*)(K + (t0_ + r16 + 32) * 512 + hd * 128 + c16 * 8); \
            pv = *(const u32x4*)(V + (t0_ + r8) * 1024 + hd * 256 + vs * 64 + c8 * 8); pp = *(const u32x4*)(PB + (size_t)it_ * 4096 + r8 * 64 + c8 * 8); \
            if (tid < 128) pd = DEC[(size_t)it_ * 128 + tid]; } while (0)
#define GC_WRITE(bo_) do { *(LAS u32x4*)(L + (bo_) + oQD + r16 * RS + c16 * 16) = pq[0]; *(LAS u32x4*)(L + (bo_) + oQD + (r16 + 32) * RS + c16 * 16) = pq[1]; \
            *(LAS u32x4*)(L + (bo_) + oKE + r16 * RS + c16 * 16) = pk[0]; *(LAS u32x4*)(L + (bo_) + oKE + (r16 + 32) * RS + c16 * 16) = pk[1]; \
            *(LAS u32x4*)(L + (bo_) + oV + r8 * RV + c8 * 16) = pv; *(LAS u32x4*)(L + (bo_) + oP + r8 * RV + c8 * 16) = pp; \
            if (tid < 128) *(LAS float*)(L + (bo_) + oDEC + tid * 4) = pd; } while (0)
        __syncthreads();
        for (int i = tid; i < 64 * RS / 16; i += 512) *(LAS u32x4*)(L + oST + i * 16) = (u32x4){0u, 0u, 0u, 0u};
        GC_LOAD(0); GC_WRITE(0);
        __syncthreads();
        const int tt = w >> 1, trow = 16 * tt + fr;
        f32x4 gnv[2]; u32x2 gq[2], gqn[2];
#pragma unroll
        for (int j = 0; j < 2; ++j) { gnv[j] = *(const f32x4*)(A.in[I_GNORM] + hd * 256 + vs * 64 + 16 * (2 * (w & 1) + j) + 4 * g);
            gqn[j] = *(const u32x2*)(GB + (tokb + trow) * 1024 + hd * 256 + vs * 64 + 16 * (2 * (w & 1) + j) + 4 * g); }
        for (int n = 0; n < 32; ++n) {
            const int cur = (n & 1) * BUF, stc = oST + (n & 1) * (64 * RS), stn = oST + ((n + 1) & 1) * (64 * RS);
            if (n + 1 < 32) GC_LOAD(n + 1);
#pragma unroll
            for (int j = 0; j < 2; ++j) { gq[j] = gqn[j]; if (n + 1 < 32) gqn[j] = *(const u32x2*)(GB + (tokb + (size_t)(n + 1) * 64 + trow) * 1024 + hd * 256 + vs * 64 + 16 * (2 * (w & 1) + j) + 4 * g); }
            bf16x8 pf[2], qf[4], vfr[2][4];
#pragma unroll
            for (int ks = 0; ks < 2; ++ks) pf[ks] = *(const LAS bf16x8*)(L + cur + oP + trow * RV + (32 * ks + 8 * g) * 2);
#pragma unroll
            for (int ks = 0; ks < 4; ++ks) qf[ks] = *(const LAS bf16x8*)(L + cur + oQD + trow * RS + (32 * ks + 8 * g) * 2);
#pragma unroll
            for (int ks = 0; ks < 2; ++ks)
#pragma unroll
                for (int vt = 0; vt < 4; ++vt) vfr[ks][vt] = tr_pair(L + cur + oV + (32 * ks + 8 * g + q4) * RV + (16 * vt + 4 * p4) * 2, 4 * RV);
            float ss = 0.f;
#pragma unroll
            for (int j = 0; j < 2; ++j) { const int vt = 2 * (w & 1) + j; f32x4 o = {0.f, 0.f, 0.f, 0.f};
                if (w & 1) {
#pragma unroll
                    for (int ks = 0; ks < 2; ++ks) o = MFMA16(vfr[ks][2 + j], pf[ks], o);
                } else {
#pragma unroll
                    for (int ks = 0; ks < 2; ++ks) o = MFMA16(vfr[ks][j], pf[ks], o);
                }
#pragma unroll
                for (int ks = 0; ks < 4; ++ks) { const bf16x8 sf = *(const LAS bf16x8*)(L + stc + (16 * vt + fr) * RS + (32 * ks + 8 * g) * 2); o = MFMA16(sf, qf[ks], o); }
                ss += o[0] * o[0] + o[1] * o[1] + o[2] * o[2] + o[3] * o[3];
                const float g0 = bf_lo(gq[j].x), g1 = bf_hi(gq[j].x), g2 = bf_lo(gq[j].y), g3 = bf_hi(gq[j].y);
                u32x2 ob; ob.x = cvt_pk_bf16(o[0] * gnv[j][0] * silu_f(g0), o[1] * gnv[j][1] * silu_f(g1)); ob.y = cvt_pk_bf16(o[2] * gnv[j][2] * silu_f(g2), o[3] * gnv[j][3] * silu_f(g3));
                *(u32x2*)(GB + (tokb + (size_t)n * 64 + trow) * 1024 + hd * 256 + vs * 64 + 16 * vt + 4 * g) = ob; }
            ss += __shfl_xor(ss, 16); ss += __shfl_xor(ss, 32);
            if (g == 0) SSQ[((tokb + (size_t)n * 64 + trow) * 4 + hd) * 8 + vs * 2 + (w & 1)] = ss;
            const f32x4 d4 = *(const LAS f32x4*)(L + cur + oDEC + (16 * w + 4 * g) * 4);
#pragma unroll
            for (int vt = 0; vt < 4; ++vt) S[vt] = S[vt] * d4;
#pragma unroll
            for (int ks = 0; ks < 2; ++ks) { const bf16x8 kf = tr_pair(L + cur + oKE + (32 * ks + 8 * g + q4) * RS + (16 * w + 4 * p4) * 2, 4 * RS);
#pragma unroll
                for (int vt = 0; vt < 4; ++vt) S[vt] = MFMA16(kf, vfr[ks][vt], S[vt]); }
#pragma unroll
            for (int vt = 0; vt < 4; ++vt) { u32x2 sb; sb.x = cvt_pk_bf16(S[vt][0], S[vt][1]); sb.y = cvt_pk_bf16(S[vt][2], S[vt][3]);
                *(LAS u32x2*)(L + stn + (16 * vt + fr) * RS + (16 * w + 4 * g) * 2) = sb; }
            if (n + 1 < 32) GC_WRITE(BUF - cur);
            LDS_BARRIER();
        }
#undef GC_LOAD
#undef GC_WRITE
    }
}

DI void phase_rnn_chain(Frame& F, const Args& A, const bool dry) {
    LAS unsigned char* L = F.lds;
    constexpr int oU = 0, RU = 272, oA = 34816, oB = 68608, RAB = 528, oH = 34816, RH = 272, oSA = 102400, oSB = 104448, oHC = 106496, oCW = 107008, oGW = 109568;
    const int tid = F.tid, lane = F.lane, w = F.wave, g = lane >> 4, fr = lane & 15, wt = w >> 1, wn = w & 1;
    const bf16_t* RX = wsp<bf16_t>(F, WS_RX); bf16_t* RY = wsp<bf16_t>(F, WS_RY); const bf16_t* RGT = wsp<bf16_t>(F, WS_RGT);
    for (int chain = F.vcu; chain < 256; chain += F.G) {
        const int b = chain >> 4, blk = (chain >> 1) & 7, half = chain & 1, C0 = blk * 128, OC0 = C0 + half * 64;
        __syncthreads();
        for (int i = tid; i < 640; i += 512) { const int k = i >> 7, c = i & 127; ((LAS float*)(L + oCW))[i] = (k < 4) ? A.in[I_CONVW][k * 1024 + C0 + c] : A.in[I_CONVB][C0 + c]; }
        if (tid < 128) ((LAS float*)(L + oHC))[tid] = 0.f;
        for (int i = tid; i < 2048; i += 512) { const int row = i >> 4, c16 = i & 15, G2 = row >> 6, ocl = row & 63;
            *(LAS u32x4*)(L + oGW + row * RU + c16 * 16) = *(const u32x4*)(RGT + ((size_t)(blk * 2 + G2) * 128 + half * 64 + ocl) * 128 + c16 * 8); }
        float ba[2], bx[2], c8[2];
#pragma unroll
        for (int nt = 0; nt < 2; ++nt) { const int oc = half * 64 + 32 * wn + 16 * nt + fr;
            ba[nt] = A.in[I_RGBA][C0 + oc]; bx[nt] = A.in[I_RGBX][C0 + oc]; c8[nt] = 8.0f * log1pf(expf(-A.in[I_LAM][C0 + oc])); }
        const int tl = tid >> 4, cg = tid & 15;
        u32x4 xr[7], yr[2];
#define RN_LOADX(t0_) do { _Pragma("unroll") for (int i_ = 0; i_ < 7; ++i_) { const int si_ = (t0_) + 4 * tl - 3 + i_; \
            xr[i_] = (si_ >= 0) ? *(const u32x4*)(RX + ((size_t)b * SEQ + si_) * 1024 + C0 + 8 * cg) : (u32x4){0u, 0u, 0u, 0u}; } } while (0)
        RN_LOADX(0);
        __syncthreads();
        for (int j = 0; j < SEQ / 128; ++j) {
            const int t0 = j * 128;
            { f32x4 cw[5][2];
#pragma unroll
              for (int k = 0; k < 5; ++k) { cw[k][0] = *(const LAS f32x4*)(L + oCW + (k * 128 + 8 * cg) * 4); cw[k][1] = *(const LAS f32x4*)(L + oCW + (k * 128 + 8 * cg + 4) * 4); }
              float xf[7][8];
#pragma unroll
              for (int i = 0; i < 7; ++i) unpack8(xr[i], xf[i]);
#pragma unroll
              for (int i = 0; i < 4; ++i) { float u8[8];
#pragma unroll
                  for (int c = 0; c < 8; ++c) { float u = cw[4][c >> 2][c & 3];
#pragma unroll
                      for (int k = 0; k < 4; ++k) u += cw[k][c >> 2][c & 3] * xf[i + k][c];
                      u8[c] = u; }
                  u32x4 uw; uw.x = cvt_pk_bf16(u8[0], u8[1]); uw.y = cvt_pk_bf16(u8[2], u8[3]); uw.z = cvt_pk_bf16(u8[4], u8[5]); uw.w = cvt_pk_bf16(u8[6], u8[7]);
                  *(LAS u32x4*)(L + oU + (4 * tl + i) * RU + cg * 16) = uw; } }
            LDS_BARRIER();
            if (j + 1 < SEQ / 128) RN_LOADX(t0 + 128);
#pragma unroll
            for (int i = 0; i < 2; ++i) { const int idx = tid + 512 * i, tok = idx >> 3, cgp = idx & 7; yr[i] = *(const u32x4*)(RY + ((size_t)b * SEQ + t0 + tok) * 1024 + OC0 + 8 * cgp); }
            f32x4 aa[2][2], ax[2][2];
#pragma unroll
            for (int mt = 0; mt < 2; ++mt)
#pragma unroll
                for (int nt = 0; nt < 2; ++nt) { aa[mt][nt] = (f32x4){0.f, 0.f, 0.f, 0.f}; ax[mt][nt] = (f32x4){0.f, 0.f, 0.f, 0.f}; }
#pragma unroll
            for (int ks = 0; ks < 4; ++ks)
#pragma unroll
                for (int mt = 0; mt < 2; ++mt) { const bf16x8 af = *(const LAS bf16x8*)(L + oU + (32 * wt + 16 * mt + fr) * RU + (32 * ks + 8 * g) * 2);
#pragma unroll
                    for (int nt = 0; nt < 2; ++nt) { const bf16x8 b0 = *(const LAS bf16x8*)(L + oGW + (32 * wn + 16 * nt + fr) * RU + (32 * ks + 8 * g) * 2), b1 = *(const LAS bf16x8*)(L + oGW + (64 + 32 * wn + 16 * nt + fr) * RU + (32 * ks + 8 * g) * 2);
                        aa[mt][nt] = MFMA16(af, b0, aa[mt][nt]); ax[mt][nt] = MFMA16(af, b1, ax[mt][nt]); } }
#pragma unroll
            for (int mt = 0; mt < 2; ++mt)
#pragma unroll
                for (int nt = 0; nt < 2; ++nt) { const int o = 32 * wn + 16 * nt + fr, tk = 32 * wt + 16 * mt + 4 * g; f32x4 av, bv;
#pragma unroll
                    for (int r = 0; r < 4; ++r) { const float uval = bf2f(*((const LAS unsigned short*)(L + oU + (tk + r) * RU) + half * 64 + o));
                        const float rg = sigmoid_f(aa[mt][nt][r] + ba[nt]), ig = sigmoid_f(ax[mt][nt][r] + bx[nt]);
                        const float a = fast_exp(-c8[nt] * rg); const float mult = __builtin_amdgcn_sqrtf(fmaxf(1.0f - a * a, 0.f));
                        av[r] = a; bv[r] = mult * ig * uval; }
                    *(LAS f32x4*)(L + oA + o * RAB + tk * 4) = av; *(LAS f32x4*)(L + oB + o * RAB + tk * 4) = bv; }
            LDS_BARRIER();
            { const int ch = tid >> 3, sg = tid & 7; float a16[16], h16[16];
#pragma unroll
              for (int q = 0; q < 4; ++q) { const f32x4 av = *(const LAS f32x4*)(L + oA + ch * RAB + (16 * sg + 4 * q) * 4), bv = *(const LAS f32x4*)(L + oB + ch * RAB + (16 * sg + 4 * q) * 4);
#pragma unroll
                  for (int r = 0; r < 4; ++r) { a16[4 * q + r] = av[r]; h16[4 * q + r] = bv[r]; } }
              float ac = 1.f, hl = 0.f;
#pragma unroll
              for (int i = 0; i < 16; ++i) { hl = a16[i] * hl + h16[i]; ac *= a16[i]; h16[i] = hl; a16[i] = ac; }
              ((LAS float*)(L + oSA))[ch * 8 + sg] = ac; ((LAS float*)(L + oSB))[ch * 8 + sg] = hl;
              LDS_BARRIER();
              float carry = ((const LAS float*)(L + oHC))[(j & 1) * 64 + ch];
#pragma unroll
              for (int s = 0; s < 7; ++s) { const float sa = ((const LAS float*)(L + oSA))[ch * 8 + s], sb = ((const LAS float*)(L + oSB))[ch * 8 + s]; carry = (s < sg) ? sa * carry + sb : carry; }
#pragma unroll
              for (int i = 0; i < 16; ++i) { const float h = h16[i] + a16[i] * carry; h16[i] = h; *(LAS float*)(L + oH + (16 * sg + i) * RH + ch * 4) = h; }
              if (sg == 7) ((LAS float*)(L + oHC))[((j + 1) & 1) * 64 + ch] = h16[15]; }
            LDS_BARRIER();
#pragma unroll
            for (int i = 0; i < 2; ++i) { const int idx = tid + 512 * i, tok = idx >> 3, cgp = idx & 7; float yf[8]; unpack8(yr[i], yf);
                const f32x4 h0 = *(const LAS f32x4*)(L + oH + tok * RH + cgp * 32), h1 = *(const LAS f32x4*)(L + oH + tok * RH + cgp * 32 + 16);
                float r[8];
#pragma unroll
                for (int c = 0; c < 4; ++c) { r[c] = h0[c] * gelu_tanh_f(yf[c]); r[4 + c] = h1[c] * gelu_tanh_f(yf[4 + c]); }
                u32x4 wv; wv.x = cvt_pk_bf16(r[0], r[1]); wv.y = cvt_pk_bf16(r[2], r[3]); wv.z = cvt_pk_bf16(r[4], r[5]); wv.w = cvt_pk_bf16(r[6], r[7]);
                if (!dry) *(u32x4*)(RY + ((size_t)b * SEQ + t0 + tok) * 1024 + OC0 + 8 * cgp) = wv; }
        }
#undef RN_LOADX
    }
}

DI void phase_ln1_router(Frame& F, const Args& A, const bf16_t* zsrc, const bool dry) {
    LAS unsigned char* L = F.lds;
    constexpr int RWB = 2064, oHI = 0, oLO = 36 * RWB;
    LAS int* HIST = (LAS int*)(L + LDSCTL_OFF + 64);
    const int tid = F.tid, lane = F.lane, w = F.wave, g = lane >> 4, fr = lane & 15;
    bf16_t* X1B = wsp<bf16_t>(F, WS_X1B); int* TOKE = wsp<int>(F, WS_TOKE); float* TOKW = wsp<float>(F, WS_TOKW);
    const bf16_t* thi = (const bf16_t*)(F.ctl + CW_RT); const float* tsw = (const float*)(F.ctl + CW_RT + 36864);
    const int m0 = F.vcu * 128 + w * 16;
    const size_t rowoff = (size_t)(m0 + fr) * D;
    __syncthreads();
    for (int i = tid; i < 2 * 36 * 128; i += 512) { const int t = i / (36 * 128), r = i % (36 * 128), n = r >> 7, c = r & 127;
        *(LAS u32x4*)(L + (t ? oLO : oHI) + n * RWB + c * 16) = *(const u32x4*)(thi + (size_t)t * 36 * 1024 + n * 1024 + c * 8); }
    if (tid < 32) HIST[tid] = 0;
    float sw[3][4], cc[3][4];
#pragma unroll
    for (int nt = 0; nt < 3; ++nt)
#pragma unroll
        for (int r = 0; r < 4; ++r) { sw[nt][r] = tsw[16 * nt + 4 * g + r]; cc[nt][r] = tsw[48 + 16 * nt + 4 * g + r]; }
    __syncthreads();
    f32x4 acc[3];
#pragma unroll
    for (int nt = 0; nt < 3; ++nt) acc[nt] = (f32x4){0.f, 0.f, 0.f, 0.f};
    const int nr2 = (32 + fr < 36) ? 32 + fr : 35;
    float s = 0.f, s2 = 0.f;
    for (int kb = 0; kb < 4; ++kb) {
        u32x4 zf[8];
#pragma unroll
        for (int i = 0; i < 8; ++i) zf[i] = *(const u32x4*)(zsrc + rowoff + 32 * (8 * kb + i) + 8 * g);
#pragma unroll
        for (int i = 0; i < 8; ++i) { const int kofs = (32 * (8 * kb + i) + 8 * g) * 2; float f[8]; unpack8(zf[i], f);
#pragma unroll
            for (int j = 0; j < 8; ++j) { s += f[j]; s2 += f[j] * f[j]; }
            const bf16x8 zb = __builtin_bit_cast(bf16x8, zf[i]);
#pragma unroll
            for (int nt = 0; nt < 3; ++nt) { const int nrow = (nt < 2) ? 16 * nt + fr : nr2;
                const bf16x8 wh = *(const LAS bf16x8*)(L + oHI + nrow * RWB + kofs), wl = *(const LAS bf16x8*)(L + oLO + nrow * RWB + kofs);
                acc[nt] = MFMA16(wh, zb, acc[nt]); acc[nt] = MFMA16(wl, zb, acc[nt]); } }
    }
    s += __shfl_xor(s, 16); s += __shfl_xor(s, 32); s2 += __shfl_xor(s2, 16); s2 += __shfl_xor(s2, 32);
    const float mean = s * (1.f / D);
    const float rstd = __builtin_amdgcn_rsqf(fmaxf(s2 * (1.f / D) - mean * mean, 0.f) + LN_EPS);
    float lg[3][4];
#pragma unroll
    for (int nt = 0; nt < 3; ++nt)
#pragma unroll
        for (int r = 0; r < 4; ++r) lg[nt][r] = rstd * (acc[nt][r] - mean * sw[nt][r]) + cc[nt][r];
    int grp = 0; float gmax = lg[2][0];
#pragma unroll
    for (int e = 1; e < 4; ++e) if (lg[2][e] > gmax) { gmax = lg[2][e]; grp = e; }
    float gs = 0.f;
#pragma unroll
    for (int e = 0; e < 4; ++e) gs += __expf(lg[2][e] - gmax);
    float pg = 1.0f / gs;
    grp = __shfl(grp, fr); pg = __shfl(pg, fr);
    const int half = grp & 1; const bool mine = (g >> 1) == half; const int eb = 4 * (g & 1);
    float v4[4];
#pragma unroll
    for (int r = 0; r < 4; ++r) v4[r] = mine ? ((grp & 2) ? lg[1][r] : lg[0][r]) : -3.0e38f;
    int i0 = 0; float m0v = v4[0];
#pragma unroll
    for (int r = 1; r < 4; ++r) if (v4[r] > m0v) { m0v = v4[r]; i0 = r; }
    int i1 = -1; float m1v = -3.0e38f;
#pragma unroll
    for (int r = 0; r < 4; ++r) if (r != i0 && v4[r] > m1v) { m1v = v4[r]; i1 = r; }
    i0 += eb; i1 += eb;
    const float pm0 = __shfl_xor(m0v, 16), pm1 = __shfl_xor(m1v, 16); const int pi0 = __shfl_xor(i0, 16), pi1 = __shfl_xor(i1, 16);
    float b0v, b1v; int b0i, b1i;
    { const bool pfirst = (pm0 > m0v) || (pm0 == m0v && pi0 < i0);
      if (pfirst) { b0v = pm0; b0i = pi0; const bool second_p = (pm1 > m0v) || (pm1 == m0v && pi1 < i0); b1v = second_p ? pm1 : m0v; b1i = second_p ? pi1 : i0; }
      else        { b0v = m0v; b0i = i0;  const bool second_m = (m1v > pm0) || (m1v == pm0 && i1 < pi0); b1v = second_m ? m1v : pm0; b1i = second_m ? i1 : pi0; } }
    const float p1 = __expf(b1v - b0v), inv = 1.0f / (1.0f + p1);
    if (mine && (g & 1) == 0 && !dry) { const int mrow = m0 + fr, e0 = grp * 8 + b0i, e1 = grp * 8 + b1i;
        TOKE[(size_t)mrow * 2] = e0; TOKE[(size_t)mrow * 2 + 1] = e1; TOKW[(size_t)mrow * 2] = pg * inv; TOKW[(size_t)mrow * 2 + 1] = pg * p1 * inv;
        atomicAdd((int*)(HIST + e0), 1); atomicAdd((int*)(HIST + e1), 1); }
    for (int kb = 0; kb < 4; ++kb) {
        u32x4 zf[8];
#pragma unroll
        for (int i = 0; i < 8; ++i) zf[i] = *(const u32x4*)(zsrc + rowoff + 32 * (8 * kb + i) + 8 * g);
#pragma unroll
        for (int i = 0; i < 8; ++i) { const int k0 = 32 * (8 * kb + i) + 8 * g; float f[8]; unpack8(zf[i], f);
            const f32x4 ga = *(const f32x4*)(A.in[I_LN1G] + k0), gb = *(const f32x4*)(A.in[I_LN1G] + k0 + 4), ba = *(const f32x4*)(A.in[I_LN1B] + k0), bb = *(const f32x4*)(A.in[I_LN1B] + k0 + 4);
            u32x4 o; o.x = cvt_pk_bf16((f[0] - mean) * rstd * ga[0] + ba[0], (f[1] - mean) * rstd * ga[1] + ba[1]); o.y = cvt_pk_bf16((f[2] - mean) * rstd * ga[2] + ba[2], (f[3] - mean) * rstd * ga[3] + ba[3]);
            o.z = cvt_pk_bf16((f[4] - mean) * rstd * gb[0] + bb[0], (f[5] - mean) * rstd * gb[1] + bb[1]); o.w = cvt_pk_bf16((f[6] - mean) * rstd * gb[2] + bb[2], (f[7] - mean) * rstd * gb[3] + bb[3]);
            if (!dry) *(u32x4*)(X1B + rowoff + k0) = o; }
    }
    __syncthreads();
    if (tid < 32 && !dry) ((int*)F.ctl)[CW_WGCNT + F.vcu * 32 + tid] = HIST[tid];
}

DI void phase_dispatch(Frame& F, const Args& A) {
    LAS int* TOT = (LAS int*)(F.lds + LDSCTL_OFF + 256); LAS int* PB = TOT + 32; LAS int* POFF = TOT + 64; LAS int* CUR = TOT + 96;
    const int tid = F.tid; const int* WGC = (const int*)F.ctl + CW_WGCNT; const int* TOKE = wsp<int>(F, WS_TOKE); const float* TOKW = wsp<float>(F, WS_TOKW);
    int* row_tok = wsp<int>(F, WS_ROWS); float* row_w = (float*)(row_tok + MAXROWS); int* row_slot = row_tok + 2 * MAXROWS;
    __syncthreads();
    if (tid < 32) { int tot = 0, before = 0; for (int g = 0; g < F.G; ++g) { const int c = WGC[g * 32 + tid]; tot += c; before += (g < F.vcu) ? c : 0; } TOT[tid] = tot; PB[tid] = before; CUR[tid] = 0; }
    __syncthreads();
    if (tid == 0) { int po = 0; for (int e = 0; e < 32; ++e) { POFF[e] = po; if (F.vcu == 0) ((int*)F.ctl)[CW_TS + e] = po >> 8; po += (TOT[e] + 255) & ~255; } if (F.vcu == 0) ((int*)F.ctl)[CW_TS + 32] = po >> 8; }
    __syncthreads();
    const int TPW = NTOK / F.G;
    for (int a = tid; a < 2 * TPW; a += 512) { const int t = F.vcu * TPW + (a >> 1), k = a & 1; const int e = TOKE[(size_t)t * 2 + k];
        const int pos = POFF[e] + PB[e] + atomicAdd((int*)(CUR + e), 1);
        row_tok[pos] = t; row_w[pos] = TOKW[(size_t)t * 2 + k]; row_slot[pos] = 2 * t + k; }
    for (int e = F.vcu; e < 32; e += F.G) { const int lo = POFF[e] + TOT[e], hi = POFF[e] + ((TOT[e] + 255) & ~255);
        for (int r = lo + tid; r < hi; r += 512) { row_tok[r] = 0; row_w[r] = 0.f; row_slot[r] = -1; } }
}

DI void phase_final(Frame& F, const Args& A, int use_moe, const bool dry) {
    const int lane = F.lane; const int gw = F.vcu * NWAVES + F.wave, NGW = F.G * NWAVES;
    float* X1 = F.out; const bf16_t* SL = wsp<bf16_t>(F, WS_SLOTS); const bf16_t* X1B = wsp<bf16_t>(F, WS_X1B);
    f32x4 g2[4], b2[4];
#pragma unroll
    for (int j = 0; j < 4; ++j) { g2[j] = *((const f32x4*)A.in[I_LN2G] + lane + 64 * j); b2[j] = *((const f32x4*)A.in[I_LN2B] + lane + 64 * j); }
    u32x2 nx[4], ns0[4], ns1[4];
#define PF_LOAD(m_) do { _Pragma("unroll") for (int j_ = 0; j_ < 4; ++j_) { nx[j_] = *(const u32x2*)(X1B + (size_t)(m_) * D + 4 * lane + 256 * j_); \
        ns0[j_] = *(const u32x2*)(SL + (size_t)(2 * (m_)) * D + 4 * lane + 256 * j_); ns1[j_] = *(const u32x2*)(SL + (size_t)(2 * (m_) + 1) * D + 4 * lane + 256 * j_); } } while (0)
    if (gw < NTOK) PF_LOAD(gw);
    for (int m = gw; m < NTOK; m += NGW) {
        f32x4 v[4]; float s = 0.f;
#pragma unroll
        for (int j = 0; j < 4; ++j) { v[j] = (f32x4){bf_lo(nx[j].x), bf_hi(nx[j].x), bf_lo(nx[j].y), bf_hi(nx[j].y)} * DN_ALPHA;
            if (use_moe) { v[j].x += bf_lo(ns0[j].x) + bf_lo(ns1[j].x); v[j].y += bf_hi(ns0[j].x) + bf_hi(ns1[j].x); v[j].z += bf_lo(ns0[j].y) + bf_lo(ns1[j].y); v[j].w += bf_hi(ns0[j].y) + bf_hi(ns1[j].y); }
            s += (v[j].x + v[j].y) + (v[j].z + v[j].w); }
        if (m + NGW < NTOK) PF_LOAD(m + NGW);
        const float mean = wave_sum(s) * (1.f / D); float s2 = 0.f;
#pragma unroll
        for (int j = 0; j < 4; ++j) { v[j] = v[j] - mean; s2 += (v[j].x * v[j].x + v[j].y * v[j].y) + (v[j].z * v[j].z + v[j].w * v[j].w); }
        const float rstd = __builtin_amdgcn_rsqf(wave_sum(s2) * (1.f / D) + LN_EPS);
#pragma unroll
        for (int j = 0; j < 4; ++j) { const f32x4 o_ = v[j] * rstd * g2[j] + b2[j]; if (!dry) *((f32x4*)(X1 + (size_t)m * D) + lane + 64 * j) = o_; }
    }
#undef PF_LOAD
}

constexpr int N_PHASES = 11;
__global__ void __launch_bounds__(NWAVES * 64, 2) fwd(Args args) {
    extern __shared__ __attribute__((aligned(16))) unsigned char lds[];
    Frame F;
    F.lds = (LAS unsigned char*)lds;
    F.tid = threadIdx.x; F.lane = F.tid & 63; F.wave = __builtin_amdgcn_readfirstlane(F.tid >> 6);
    F.G = gridDim.x; { const int bx = blockIdx.x; F.vcu = (F.G % 8 == 0) ? (bx % 8) * (F.G / 8) + bx / 8 : bx; }
    F.ws = args.ws; F.ctl = (unsigned*)(args.ws + WS_CTL); F.out = args.out;
    for (int u = F.tid; u < (LDS_BYTES - LDSCTL_OFF) / 4; u += NWAVES * 64) ((LAS unsigned*)(F.lds + LDSCTL_OFF))[u] = 0u;
    __syncthreads();
    const int lo = args.ph_lo, hi = args.ph_hi;
    XcdBarrier bar; bar.bar = F.ctl + CW_BAR; bar.x = 0; bar.st = nullptr;
    if (hi - lo > 1) bar = xcd_barrier_post(F.ctl + CW_BAR, (volatile LAS unsigned*)(F.lds + LDSCTL_OFF));
#define IN(k) (lo <= (k) && (k) < hi)
#define SEAM(k) do { if (IN(k) && IN((k) + 1)) xcd_barrier(bar); } while (0)
    LAS unsigned char* ring = F.lds;
    constexpr int ST = MK_STAGE;
#define DUP(k) ((MK_DUP >> (k)) & 1)
    if (IN(0)) { if (DUP(0)) p0_prologue(F, args); p0_prologue(F, args); } SEAM(0);
    if (IN(1)) {
#pragma unroll
        for (int rep = 0; rep < 1 + DUP(1); ++rep) {
        pg8::StaticOrder S; S.init(wsp<bf16_t>(F, WS_XB), wsp<bf16_t>(F, WS_WIN), NTOK, NPROJ, D, F.G, (int)blockIdx.x);
        EpiProj E{wsp<bf16_t>(F, WS_RX), wsp<bf16_t>(F, WS_RY), wsp<bf16_t>(F, WS_Q), wsp<bf16_t>(F, WS_K), wsp<bf16_t>(F, WS_V), wsp<bf16_t>(F, WS_G), (bf16_t*)F.out, (bf16_t*)F.out + (size_t)NTOK * D, args.in[I_BIN]};
        pg8::gemm_phase<EpiProj, pg8::StaticOrder, pg8::NoHook, false, true, true>(ring, D, S, E, pg8::NoHook{}); } } SEAM(1);
    if (IN(2)) { if (DUP(2)) { phase_gla_pre(F, args, args.dup != 0); phase_rnn_chain(F, args, args.dup != 0); } phase_gla_pre(F, args, false); phase_rnn_chain(F, args, false); } SEAM(2);
    if (IN(3)) { phase_gla_chain(F, args); } SEAM(3);
    if (IN(4)) {
#pragma unroll
      for (int rep4 = 0; rep4 < 1 + DUP(4); ++rep4) {
        LAS float* rstab = (LAS float*)(F.lds + AUX_OFF);
        { pg8::StaticOrder S0; S0.init(wsp<bf16_t>(F, WS_RY), wsp<bf16_t>(F, WS_WR), NTOK, D, D, F.G, (int)blockIdx.x);
          pg8::Unit u; const int ui = F.tid >> 8, r = F.tid & 255;
          __syncthreads();
          if (S0.next(ui, u)) { const float* sq = wsp<float>(F, WS_SSQ) + ((size_t)(u.pm * 256 + r) * 4) * 8; f32x4 o;
#pragma unroll
              for (int h = 0; h < 4; ++h) { const f32x4 s0 = *(const f32x4*)(sq + h * 8), s1 = *(const f32x4*)(sq + h * 8 + 4); o[h] = __builtin_amdgcn_rsqf(((s0.x + s0.y) + (s0.z + s0.w) + (s1.x + s1.y) + (s1.z + s1.w)) * (1.0f / 256.0f) + RMS_EPS); }
              *(LAS f32x4*)(rstab + (ui * 256 + r) * 4) = o; }
          __syncthreads(); }
        { pg8::StaticOrder S; S.init(wsp<bf16_t>(F, WS_RY), wsp<bf16_t>(F, WS_WR), NTOK, D, D, F.G, (int)blockIdx.x);
          EpiMergeA E{(const bf16_t*)F.out, wsp<bf16_t>(F, WS_TMP)};
          pg8::gemm_phase<EpiMergeA, pg8::StaticOrder, pg8::NoHook, false, true, true>(ring, D, S, E, pg8::NoHook{}); }
        { pg8::StaticOrder S; S.init(wsp<bf16_t>(F, WS_G), wsp<bf16_t>(F, WS_WG), NTOK, D, D, F.G, (int)blockIdx.x);
          RowHook H{rstab};
          EpiMergeB E{(const bf16_t*)F.out + (size_t)NTOK * D, wsp<bf16_t>(F, WS_TMP), wsp<bf16_t>(F, WS_MERGED), rstab};
          pg8::gemm_phase<EpiMergeB, pg8::StaticOrder, RowHook, false, true, true>(ring, D, S, E, H); } } } SEAM(4);
    if (IN(5)) {
#pragma unroll
        for (int rep = 0; rep < 1 + DUP(5); ++rep) {
        pg8::StaticOrder S; S.init(wsp<bf16_t>(F, WS_MERGED), wsp<bf16_t>(F, WS_WO), NTOK, D, D, F.G, (int)blockIdx.x);
        EpiWo E{wsp<bf16_t>(F, WS_XB), args.in[I_BO], wsp<bf16_t>(F, WS_Z1)};
        pg8::gemm_phase<EpiWo, pg8::StaticOrder, pg8::NoHook, false, true, true>(ring, D, S, E, pg8::NoHook{}); } } SEAM(5);
    if (IN(6)) { if (DUP(6)) phase_ln1_router(F, args, wsp<bf16_t>(F, WS_Z1), args.dup != 0); phase_ln1_router(F, args, wsp<bf16_t>(F, WS_Z1), false); } SEAM(6);
    if (IN(7)) { if (DUP(7)) phase_dispatch(F, args); phase_dispatch(F, args); } SEAM(7);
    if (IN(8)) {
#pragma unroll
        for (int rep = 0; rep < 1 + DUP(8); ++rep) {
        LAS int* ts = (LAS int*)(F.lds + LDSCTL_OFF + 768);
        __syncthreads(); if (F.tid < 33) ts[F.tid] = ((const int*)F.ctl)[CW_TS + F.tid]; __syncthreads();
        MoeOrder S{(const char*)wsp<bf16_t>(F, WS_X1B), (const char*)wsp<bf16_t>(F, WS_E13), D, (size_t)1024 * 1024 * 2, ts, wsp<int>(F, WS_ROWS), F.G, (int)blockIdx.x, 1};
        EpiExp1 E{wsp<bf16_t>(F, WS_H)};
        pg8::gemm_phase<EpiExp1, MoeOrder, pg8::NoHook, true, true, true>(ring, D, S, E, pg8::NoHook{}); } } SEAM(8);
    if (IN(9)) {
#pragma unroll
        for (int rep = 0; rep < 1 + DUP(9); ++rep) {
        LAS int* ts = (LAS int*)(F.lds + LDSCTL_OFF + 768);
        __syncthreads(); if (F.tid < 33) ts[F.tid] = ((const int*)F.ctl)[CW_TS + F.tid]; __syncthreads();
        MoeOrder S{(const char*)wsp<bf16_t>(F, WS_H), (const char*)wsp<bf16_t>(F, WS_E2), FF, (size_t)1024 * 512 * 2, ts, wsp<int>(F, WS_ROWS), F.G, (int)blockIdx.x, 0};
        EpiExp2 E{wsp<int>(F, WS_ROWS) + 2 * MAXROWS, (const float*)(wsp<int>(F, WS_ROWS) + MAXROWS), wsp<bf16_t>(F, WS_SLOTS)};
        pg8::gemm_phase<EpiExp2, MoeOrder, pg8::NoHook, false, true, true>(ring, FF, S, E, pg8::NoHook{}); } } SEAM(9);
    if (IN(10)) { if (DUP(10)) phase_final(F, args, 1, args.dup != 0); phase_final(F, args, 1, false); }
#undef IN
#undef SEAM
}

extern "C" void kernel_launch(void* const* d_in, const int* in_sizes, int n_in, void* d_out, int out_size, void* d_ws, size_t ws_size, hipStream_t stream) {
    static int grid = 0;
    if (grid == 0) {
        if (n_in != 28 || in_sizes[0] != NTOK * D || out_size != NTOK * D || ws_size < WS_END) { fprintf(stderr, "kernel_launch: unexpected shapes (n_in %d, in0 %d, out %d, ws %zu); nothing launched\n", n_in, n_in > 0 ? in_sizes[0] : -1, out_size, ws_size); grid = -1; return; }
        int dev = 0, cus = 0, per_cu = 0;
        if (hipGetDevice(&dev) != hipSuccess || hipDeviceGetAttribute(&cus, hipDeviceAttributeMultiprocessorCount, dev) != hipSuccess) { grid = -1; return; }
        if (hipFuncSetAttribute((const void*)fwd, hipFuncAttributeMaxDynamicSharedMemorySize, LDS_BYTES) != hipSuccess) { fprintf(stderr, "kernel_launch: hipFuncSetAttribute failed\n"); grid = -1; return; }
        if (hipOccupancyMaxActiveBlocksPerMultiprocessor(&per_cu, (const void*)fwd, NWAVES * 64, LDS_BYTES) != hipSuccess || per_cu < 1) { fprintf(stderr, "kernel_launch: occupancy query reports %d workgroups per CU\n", per_cu); }
        (void)hipGetLastError();
        grid = cus;
        if (grid != 256) { fprintf(stderr, "kernel_launch: built for 256 CUs, found %d; nothing launched\n", cus); grid = -1; return; }
    }
    if (grid < 0) return;
    if (hipMemsetAsync((char*)d_ws + WS_CTL, 0, CTL_ZERO_BYTES, stream) != hipSuccess) return;
    Args a{};
    for (int i = 0; i < 28; ++i) a.in[i] = (const float*)d_in[i];
    a.out = (float*)d_out; a.ws = (unsigned char*)d_ws; a.dup = MK_DUP; a.pad = 0;
#if MK_ONE_LAUNCH
    a.ph_lo = 0; a.ph_hi = N_PHASES;
    hipLaunchKernelGGL(fwd, dim3(grid), dim3(NWAVES * 64), LDS_BYTES, stream, a);
#else
    for (int p = 0; p < N_PHASES; ++p) { a.ph_lo = p; a.ph_hi = p + 1; hipLaunchKernelGGL(fwd, dim3(grid), dim3(NWAVES * 64), LDS_BYTES, stream, a); }
#endif
}
```
